# Optimizing an MI355X kernel written in HIP

```python
import math
import jax, jax.numpy as jnp
from jax import lax
import numpy as np

D_MODEL = 2048
BATCH = 2
SEQ = 4096
DEPTH = 1

CHUNK = 64
D_MIX = D_MODEL
D_CONV = D_MIX // 2
D_SSM = D_MIX - D_CONV
CONV_WIDTH = 31
SSM_GROUP = 16
SSM_GROUPS = D_SSM // SSM_GROUP
SSM_STATE = 64
N_MEM = 256
MEM_HEADS = 4
MEM_HEAD_DIM = D_MODEL // MEM_HEADS
PEER_HEADS = 8
PEER_KEYS = 128
PEER_EXPERTS = PEER_KEYS * PEER_KEYS
PEER_DKEY = 128
PEER_HALF = PEER_DKEY // 2
PEER_TOPK = 16
PEER_BLOCK = 128
EPS = 1e-6

kernel_name = "hybrid_conv_s5_peer_memxattn"

F32 = jnp.float32


def rms_norm(x, g):
    xf = x.astype(F32)
    y = xf * lax.rsqrt(jnp.mean(xf * xf, axis=-1, keepdims=True) + EPS)
    return (y * g.astype(F32)).astype(x.dtype)


def layer_norm(x, g, b):
    xf = x.astype(F32)
    mu = jnp.mean(xf, axis=-1, keepdims=True)
    xc = xf - mu
    y = xc * lax.rsqrt(jnp.mean(xc * xc, axis=-1, keepdims=True) + EPS)
    return (y * g.astype(F32) + b.astype(F32)).astype(x.dtype)


def causal_depthwise_conv(x, w, b):
    k = w.shape[0]
    y = lax.conv_general_dilated(
        x, w[:, None, :].astype(x.dtype), window_strides=(1,), padding=[(k - 1, 0)],
        dimension_numbers=("NWC", "WIO", "NWC"), feature_group_count=x.shape[-1])
    return y + b.astype(x.dtype)


def conformer_conv_group(a, gate, conv_w, conv_b, ln_g, ln_b):
    c = a * jax.nn.sigmoid(gate)
    c = causal_depthwise_conv(c, conv_w, conv_b)
    c = layer_norm(c, ln_g, ln_b)
    return c * jax.nn.sigmoid(c)


def s5_group(u, lam_re, lam_im, log_dt, b_re, b_im, c_re, c_im, d, glu_w):
    bsz, length, _ = u.shape
    uf = u.astype(F32).reshape(bsz, length, SSM_GROUPS, SSM_GROUP)
    lam = lax.complex(lam_re.astype(F32), lam_im.astype(F32))
    dt = jnp.exp(log_dt.astype(F32))[:, None]
    lam_bar = jnp.exp(lam * dt)
    b = lax.complex(b_re.astype(F32), b_im.astype(F32))
    b_bar = ((lam_bar - 1.0) / lam)[..., None] * b
    bu = jnp.einsum("blgh,gph->blgp", uf.astype(jnp.complex64), b_bar)
    a = jnp.broadcast_to(lam_bar, bu.shape)

    def combine(left, right):
        a_l, s_l = left
        a_r, s_r = right
        return a_r * a_l, a_r * s_l + s_r

    _, states = lax.associative_scan(combine, (a, bu), axis=1)
    c = lax.complex(c_re.astype(F32), c_im.astype(F32))
    y = jnp.real(jnp.einsum("blgp,ghp->blgh", states, c))
    y = y + d.astype(F32).reshape(SSM_GROUPS, SSM_GROUP) * uf
    y = y.reshape(bsz, length, D_SSM).astype(u.dtype)
    z = jax.nn.gelu(y)
    return z * jax.nn.sigmoid(z @ glu_w)


def mem_cross_attention(h, mem_n, w_q, w_kv, w_o):
    bsz, length, _ = h.shape
    q = (h @ w_q).reshape(bsz, length, MEM_HEADS, MEM_HEAD_DIM)
    kv = (mem_n @ w_kv).reshape(bsz, mem_n.shape[1], 2, MEM_HEADS, MEM_HEAD_DIM)
    k, v = kv[:, :, 0], kv[:, :, 1]
    s = jnp.einsum("blhd,bmhd->bhlm", q, k).astype(F32) * (1.0 / math.sqrt(MEM_HEAD_DIM))
    p = jax.nn.softmax(s, axis=-1).astype(h.dtype)
    o = jnp.einsum("bhlm,bmhd->blhd", p, v).reshape(bsz, length, D_MODEL)
    return o @ w_o


def peer(h, w_q, sub_keys, u_tab, v_tab):
    bsz, length, dm = h.shape
    q = (h @ w_q).astype(F32).reshape(bsz, length, PEER_HEADS, 2, PEER_HALF)
    s = jnp.einsum("blhsk,hsnk->blhsn", q, sub_keys.astype(F32))
    s1, i1 = lax.top_k(s[..., 0, :], PEER_TOPK)
    s2, i2 = lax.top_k(s[..., 1, :], PEER_TOPK)
    cand_s = (s1[..., :, None] + s2[..., None, :]).reshape(bsz, length, PEER_HEADS, PEER_TOPK * PEER_TOPK)
    cand_i = (i1[..., :, None] * PEER_KEYS + i2[..., None, :]).reshape(bsz, length, PEER_HEADS, PEER_TOPK * PEER_TOPK)
    top_s, pos = lax.top_k(cand_s, PEER_TOPK)
    idx = jnp.take_along_axis(cand_i, pos, axis=-1)
    g = jax.nn.softmax(top_s, axis=-1)
    n_tok = bsz * length
    nb = n_tok // PEER_BLOCK
    xb = h.reshape(nb, PEER_BLOCK, dm)
    ib = idx.reshape(nb, PEER_BLOCK, PEER_HEADS * PEER_TOPK)
    gb = g.astype(h.dtype).reshape(nb, PEER_BLOCK, PEER_HEADS * PEER_TOPK)

    def block(args):
        xt, it, gt = args
        u = jnp.take(u_tab, it, axis=0)
        act = jax.nn.gelu(jnp.einsum("td,tkd->tk", xt, u))
        v = jnp.take(v_tab, it, axis=0)
        return jnp.einsum("tk,tkd->td", gt * act, v)

    out = lax.map(block, (xb, ib, gb))
    return out.reshape(bsz, length, dm)


def setup_inputs(seed: int = 0) -> dict:
    key = jax.random.key(seed)
    ks = iter(jax.random.split(key, 40))
    nrm = lambda shape, scale: jax.random.normal(next(ks), shape, F32) * scale
    gain = lambda shape: 1.0 + 0.05 * jax.random.normal(next(ks), shape, F32)
    L = DEPTH
    n_in = 2 * D_CONV + D_SSM
    lam_re = -0.5 + 0.01 * jax.random.normal(next(ks), (L, SSM_GROUPS, SSM_STATE), F32)
    lam_im = (math.pi * jnp.arange(SSM_STATE, dtype=F32))[None, None, :] + 0.01 * jax.random.normal(next(ks), (L, SSM_GROUPS, SSM_STATE), F32)
    log_dt = jax.random.uniform(next(ks), (L, SSM_GROUPS), F32, math.log(1e-3), math.log(1e-1))
    return {
        "x": nrm((BATCH, SEQ, D_MODEL), 1.0),
        "mem": nrm((BATCH, N_MEM, D_MODEL), 1.0),
        "norm_mix_g": gain((L, D_MODEL)),
        "w_in": nrm((L, D_MODEL, n_in), D_MODEL ** -0.5),
        "conv_w": nrm((L, CONV_WIDTH, D_CONV), CONV_WIDTH ** -0.5),
        "conv_b": nrm((L, D_CONV), 0.02),
        "conv_ln_g": gain((L, D_CONV)),
        "conv_ln_b": nrm((L, D_CONV), 0.02),
        "ssm_lam_re": lam_re,
        "ssm_lam_im": lam_im,
        "ssm_log_dt": log_dt,
        "ssm_b_re": nrm((L, SSM_GROUPS, SSM_STATE, SSM_GROUP), (2.0 * SSM_GROUP) ** -0.5),
        "ssm_b_im": nrm((L, SSM_GROUPS, SSM_STATE, SSM_GROUP), (2.0 * SSM_GROUP) ** -0.5),
        "ssm_c_re": nrm((L, SSM_GROUPS, SSM_GROUP, SSM_STATE), (2.0 * SSM_STATE) ** -0.5),
        "ssm_c_im": nrm((L, SSM_GROUPS, SSM_GROUP, SSM_STATE), (2.0 * SSM_STATE) ** -0.5),
        "ssm_d": nrm((L, D_SSM), 1.0),
        "ssm_glu_w": nrm((L, D_SSM, D_SSM), D_SSM ** -0.5),
        "grp_norm_conv_g": gain((L, D_CONV)),
        "grp_norm_ssm_g": gain((L, D_SSM)),
        "w_out": nrm((L, D_MIX, D_MODEL), D_MIX ** -0.5),
        "norm_mem_g": gain((L, D_MODEL)),
        "mem_norm_g": gain((L, D_MODEL)),
        "w_q_mem": nrm((L, D_MODEL, D_MODEL), D_MODEL ** -0.5),
        "w_kv_mem": nrm((L, D_MODEL, 2 * D_MODEL), D_MODEL ** -0.5),
        "w_o_mem": nrm((L, D_MODEL, D_MODEL), D_MODEL ** -0.5),
        "norm_ffn_g": gain((L, D_MODEL)),
        "peer_w_q": nrm((L, D_MODEL, PEER_HEADS * PEER_DKEY), D_MODEL ** -0.5),
        "peer_keys": nrm((L, PEER_HEADS, 2, PEER_KEYS, PEER_HALF), PEER_HALF ** -0.5),
        "peer_u": nrm((L, PEER_EXPERTS, D_MODEL), D_MODEL ** -0.5),
        "peer_v": nrm((L, PEER_EXPERTS, D_MODEL), PEER_TOPK ** -0.5),
        "final_norm_g": gain((D_MODEL,)),
    }


def reference(x, mem, norm_mix_g, w_in, conv_w, conv_b, conv_ln_g, conv_ln_b,
              ssm_lam_re, ssm_lam_im, ssm_log_dt, ssm_b_re, ssm_b_im, ssm_c_re, ssm_c_im,
              ssm_d, ssm_glu_w, grp_norm_conv_g, grp_norm_ssm_g, w_out,
              norm_mem_g, mem_norm_g, w_q_mem, w_kv_mem, w_o_mem,
              norm_ffn_g, peer_w_q, peer_keys, peer_u, peer_v, final_norm_g):
    h = x
    for i in range(DEPTH):
        hn = rms_norm(h, norm_mix_g[i])
        proj = hn @ w_in[i]
        conv_a = proj[..., :D_CONV]
        conv_gate = proj[..., D_CONV:2 * D_CONV]
        ssm_u = proj[..., 2 * D_CONV:]
        yc = conformer_conv_group(conv_a, conv_gate, conv_w[i], conv_b[i], conv_ln_g[i], conv_ln_b[i])
        ys = s5_group(ssm_u, ssm_lam_re[i], ssm_lam_im[i], ssm_log_dt[i], ssm_b_re[i], ssm_b_im[i],
                      ssm_c_re[i], ssm_c_im[i], ssm_d[i], ssm_glu_w[i])
        y = jnp.concatenate([rms_norm(yc, grp_norm_conv_g[i]), rms_norm(ys, grp_norm_ssm_g[i])], axis=-1)
        h = h + y @ w_out[i]
        hn = rms_norm(h, norm_mem_g[i])
        mem_n = rms_norm(mem, mem_norm_g[i])
        h = h + mem_cross_attention(hn, mem_n, w_q_mem[i], w_kv_mem[i], w_o_mem[i])
        hn = rms_norm(h, norm_ffn_g[i])
        h = h + peer(hn, peer_w_q[i], peer_keys[i], peer_u[i], peer_v[i])
    return rms_norm(h, final_norm_g)
```

```cpp
#include <hip/hip_runtime.h>
#include <cstdio>
#include <cstdint>
namespace pg8 {
#define PG8_LAS __attribute__((address_space(3)))
typedef unsigned short bf16_t;
typedef short bf16x8 __attribute__((ext_vector_type(8)));
typedef float f32x4 __attribute__((ext_vector_type(4)));
typedef unsigned u32x4 __attribute__((ext_vector_type(4)));
constexpr int BM = 256, BK = 64, HALF = 128, HTB = HALF * BK * 2  , STAGE_BYTES = 8 * HTB, NXCD = 8, WGM = 8;

__host__ __device__ __forceinline__ int lds_byte(int r, int c) { const int st = (r >> 4) * 2 + (c >> 5), rr = r & 15, cc = c & 31, ob = rr * 64 + cc * 2; return st * 1024 + (ob ^ (((ob >> 9) & 1) << 5)); }
__host__ __device__ __forceinline__ void stage_rc(int b, int& R, int& C) { const int st = b / 1024, sb = b % 1024, swz = sb ^ (((sb >> 9) & 1) << 5); R = (st >> 1) * 16 + swz / 64; C = (st & 1) * 32 + (swz % 64) / 2; }
__host__ __device__ __forceinline__ int perm32(int rho) { const int n = rho >> 4, i = rho & 15; return 8 * (i >> 2) + 4 * n + (i & 3); }

struct Unit { int pm, pn; };
struct Gemm { const bf16_t* A; const bf16_t* Bt; int M, N, K, lda, ldb; };

struct StaticOrder {
    int nM, nN, nwg, G, c;
    __host__ __device__ void init(int M, int N, int G_, int c_) { nM = M / BM; nN = N / BM; nwg = nM * nN; G = G_; c = c_; }
    __host__ __device__ bool next(int i, Unit& u) const {
        const long L = (long)i * G + c; if (L >= nwg) return false;
        int wgid = (int)L; { const int q = nwg / NXCD, r = nwg % NXCD, xcd = wgid % NXCD, off = wgid / NXCD; wgid = (xcd < r ? xcd * (q + 1) : r * (q + 1) + (xcd - r) * q) + off; }
        const int nig = WGM * nN, gid = wgid / nig, fm = gid * WGM, gsz = (nM - fm) < WGM ? (nM - fm) : WGM;
        u.pm = fm + ((wgid % nig) % gsz); u.pn = (wgid % nig) / gsz; return true;
    }
    __device__ __forceinline__ void a_ready(const Unit&) const {}
    __device__ __forceinline__ void done(const Unit&) const {}
};

__device__ __forceinline__ unsigned cvt_pk_bf16(float lo, float hi) { unsigned r; asm volatile("v_cvt_pk_bf16_f32 %0, %1, %2" : "=v"(r) : "v"(lo), "v"(hi)); return r; }

template <class Epi, class Sched, bool ALIGN_EPI = false, bool SP2 = false>
__device__ __forceinline__ void gemm_phase(PG8_LAS unsigned char* lds, const Gemm g, const Sched& S, const Epi& E) {
    int tid_ = threadIdx.x; asm volatile("" : "+v"(tid_));
    const int tid = tid_, wid = __builtin_amdgcn_readfirstlane(tid >> 6), lane = tid & 63, wr = wid >> 2, wc = wid & 3, fr = lane & 15, fq = lane >> 4;
    const int K = g.K, nt = K / BK;
    unsigned voffA[2], voffB[2];
#pragma unroll
    for (int i = 0; i < 2; ++i) { int R, C; stage_rc(tid * 16 + i * 8192, R, C); const int Rb = Epi::PERM ? ((R & ~31) + perm32(R & 31)) : R;
        voffA[i] = (unsigned)(R * g.lda + C) * 2u; voffB[i] = (unsigned)(Rb * g.ldb + C) * 2u; }
    const size_t kstep = (size_t)(BK * 2);
    const size_t hstepA = (size_t)HALF * g.lda * 2, hstepB = (size_t)HALF * g.ldb * 2;
    const size_t tstepA = 2 * hstepA, tstepB = 2 * hstepB;
    const unsigned ldsw = (unsigned)wid * 1024u;
    const int aoff = lds_byte(wr * 64 + fr, fq * 8), boff = lds_byte(wc * 32 + fr, fq * 8);
#define PG8_SA(b, h) (((b) * 2 + (h)) * HTB)
#define PG8_SB(b, h) ((4 + (b) * 2 + (h)) * HTB)
#define PG8_STAGE(bufoff, gbase, voff) do { _Pragma("unroll") for (int _i = 0; _i < 2; ++_i) \
        __builtin_amdgcn_global_load_lds((const unsigned*)((const char*)(gbase) + (voff)[_i]), (PG8_LAS unsigned*)(lds + (bufoff) + ldsw + _i * 8192), 16, 0, 0); } while (0)
#define PG8_LDA(dst, b, h) do { _Pragma("unroll") for (int m = 0; m < 4; ++m) _Pragma("unroll") for (int k = 0; k < 2; ++k) dst[m][k] = *(const PG8_LAS bf16x8*)(lds + PG8_SA(b, h) + aoff + m * 2048 + k * 1024); } while (0)
#define PG8_LDB(dst, b, h) do { _Pragma("unroll") for (int n = 0; n < 2; ++n) _Pragma("unroll") for (int k = 0; k < 2; ++k) dst[n][k] = *(const PG8_LAS bf16x8*)(lds + PG8_SB(b, h) + boff + n * 2048 + k * 1024); } while (0)
#define PG8_MMA(ai, bj, At, Bt) do { __builtin_amdgcn_s_setprio(1); _Pragma("unroll") for (int m = 0; m < 4; ++m) _Pragma("unroll") for (int n = 0; n < 2; ++n) _Pragma("unroll") for (int k = 0; k < 2; ++k) \
        acc[ai][bj][m][n] = __builtin_amdgcn_mfma_f32_16x16x32_bf16(Bt[n][k], At[m][k], acc[ai][bj][m][n], 0, 0, 0); __builtin_amdgcn_s_setprio(0); } while (0)
#define PG8_WAIT_V(n) asm volatile("s_waitcnt vmcnt(" #n ")" ::: "memory")
#define PG8_WAIT_L(n) asm volatile("s_waitcnt lgkmcnt(" #n ")" ::: "memory")
#define PG8_BAR __builtin_amdgcn_s_barrier()
#define PG8_SCHED __builtin_amdgcn_sched_barrier(0)
    Unit cur, nxt; int ui = 0;
    if (!S.next(0, cur)) return;
    f32x4 acc[2][2][4][2];
#pragma unroll
    for (int a = 0; a < 2; ++a)
#pragma unroll
        for (int b = 0; b < 2; ++b)
#pragma unroll
            for (int m = 0; m < 4; ++m)
#pragma unroll
                for (int n = 0; n < 2; ++n) acc[a][b][m][n] = (f32x4){0.f, 0.f, 0.f, 0.f};
    bf16x8 At[4][2], B0[2][2], B1[2][2];
    const char* cA = (const char*)g.A + (size_t)cur.pm * tstepA; const char* cB = (const char*)g.Bt + (size_t)cur.pn * tstepB;
    S.a_ready(cur);
    if constexpr (SP2) {
        PG8_STAGE(PG8_SB(0, 0), cB, voffB); PG8_STAGE(PG8_SB(0, 1), cB + hstepB, voffB); PG8_STAGE(PG8_SA(0, 0), cA, voffA); PG8_STAGE(PG8_SA(0, 1), cA + hstepA, voffA);
        if (wr == 1) PG8_BAR;
        PG8_WAIT_V(2); PG8_BAR;
        PG8_STAGE(PG8_SB(1, 0), cB + kstep, voffB); PG8_STAGE(PG8_SA(1, 0), cA + kstep, voffA); PG8_STAGE(PG8_SB(1, 1), cB + hstepB + kstep, voffB);
        PG8_WAIT_V(6); PG8_BAR;
    } else {
        PG8_STAGE(PG8_SB(0, 0), cB, voffB); PG8_STAGE(PG8_SA(0, 0), cA, voffA); PG8_STAGE(PG8_SB(0, 1), cB + hstepB, voffB); PG8_STAGE(PG8_SA(0, 1), cA + hstepA, voffA);
        if (wr == 1) PG8_BAR;
        PG8_WAIT_V(4); PG8_BAR;
        PG8_STAGE(PG8_SB(1, 0), cB + kstep, voffB); PG8_STAGE(PG8_SA(1, 0), cA + kstep, voffA); PG8_STAGE(PG8_SB(1, 1), cB + hstepB + kstep, voffB);
        PG8_WAIT_V(6); PG8_BAR;
    }
    for (;;) {
        const bool has_next = S.next(ui + 1, nxt);
        const char* nA = has_next ? (const char*)g.A + (size_t)nxt.pm * tstepA : cA; const char* nB = has_next ? (const char*)g.Bt + (size_t)nxt.pn * tstepB : cB;
        for (int t = 0; t < nt; t += 2) {
            if constexpr (Epi::MIDK) { if (t == (nt >> 1)) E.midk(acc, cur, wr, wc, fr, fq); }
            const bool last = (t == nt - 2);
            const char* a1 = cA + (size_t)(t + 1) * kstep;
            const char* a2 = last ? nA : cA + (size_t)(t + 2) * kstep; const char* b2 = last ? nB : cB + (size_t)(t + 2) * kstep;
            const char* a3 = a2 + kstep; const char* b3 = b2 + kstep;
            if (last && has_next) S.a_ready(nxt);
            if constexpr (SP2) {
            PG8_LDB(B0, 0, 0); PG8_LDB(B1, 0, 1); PG8_SCHED; PG8_LDA(At, 0, 0); PG8_STAGE(PG8_SA(1, 1), a1 + hstepA, voffA);
            PG8_WAIT_V(8); PG8_WAIT_L(0); PG8_BAR; PG8_MMA(0, 0, At, B0); PG8_MMA(0, 1, At, B1); PG8_BAR; PG8_SCHED;
            PG8_LDA(At, 0, 1); PG8_STAGE(PG8_SB(0, 0), b2, voffB); PG8_STAGE(PG8_SB(0, 1), b2 + hstepB, voffB); PG8_STAGE(PG8_SA(0, 0), a2, voffA);
            PG8_WAIT_V(8); PG8_WAIT_L(0); PG8_BAR; PG8_MMA(1, 0, At, B0); PG8_MMA(1, 1, At, B1); PG8_BAR; PG8_SCHED;
            PG8_LDB(B0, 1, 0); PG8_LDB(B1, 1, 1); PG8_SCHED; PG8_LDA(At, 1, 0); PG8_STAGE(PG8_SA(0, 1), a2 + hstepA, voffA);
            PG8_WAIT_V(8); PG8_WAIT_L(0); PG8_BAR; PG8_MMA(0, 0, At, B0); PG8_MMA(0, 1, At, B1); PG8_BAR; PG8_SCHED;
            PG8_LDA(At, 1, 1); PG8_STAGE(PG8_SB(1, 0), b3, voffB); PG8_STAGE(PG8_SB(1, 1), b3 + hstepB, voffB); PG8_STAGE(PG8_SA(1, 0), a3, voffA);
            PG8_WAIT_V(8); PG8_WAIT_L(0); PG8_BAR; PG8_MMA(1, 0, At, B0); PG8_MMA(1, 1, At, B1); PG8_BAR; PG8_SCHED;
            } else {
            PG8_LDB(B0, 0, 0); PG8_SCHED; PG8_LDA(At, 0, 0); PG8_STAGE(PG8_SA(1, 1), a1 + hstepA, voffA);
            PG8_WAIT_L(8); PG8_BAR; PG8_WAIT_L(0); PG8_MMA(0, 0, At, B0); PG8_BAR; PG8_SCHED;
            PG8_LDB(B1, 0, 1); PG8_STAGE(PG8_SB(0, 0), b2, voffB);
            PG8_BAR; PG8_WAIT_L(0); PG8_MMA(0, 1, At, B1); PG8_BAR;
            PG8_LDA(At, 0, 1); PG8_STAGE(PG8_SA(0, 0), a2, voffA);
            PG8_BAR; PG8_WAIT_L(0); PG8_MMA(1, 0, At, B0); PG8_BAR; PG8_SCHED;
            PG8_STAGE(PG8_SB(0, 1), b2 + hstepB, voffB);
            PG8_WAIT_V(6); PG8_BAR; PG8_MMA(1, 1, At, B1); PG8_BAR;
            PG8_LDB(B0, 1, 0); PG8_SCHED; PG8_LDA(At, 1, 0); PG8_STAGE(PG8_SA(0, 1), a2 + hstepA, voffA);
            PG8_WAIT_L(8); PG8_BAR; PG8_WAIT_L(0); PG8_MMA(0, 0, At, B0); PG8_BAR; PG8_SCHED;
            PG8_LDB(B1, 1, 1); PG8_STAGE(PG8_SB(1, 0), b3, voffB);
            PG8_BAR; PG8_WAIT_L(0); PG8_MMA(0, 1, At, B1); PG8_BAR;
            PG8_LDA(At, 1, 1); PG8_STAGE(PG8_SA(1, 0), a3, voffA);
            PG8_BAR; PG8_WAIT_L(0); PG8_MMA(1, 0, At, B0); PG8_BAR; PG8_SCHED;
            PG8_STAGE(PG8_SB(1, 1), b3 + hstepB, voffB);
            PG8_WAIT_V(6); PG8_BAR; PG8_MMA(1, 1, At, B1); PG8_BAR;
            }
        }
        if constexpr (ALIGN_EPI) { if (wr == 0) PG8_BAR; }
        if constexpr (!Epi::AFTER_DRAIN) { E(acc, cur, wr, wc, fr, fq); S.done(cur); }
        if (!has_next) break;
#pragma unroll
        for (int a = 0; a < 2; ++a)
#pragma unroll
            for (int b = 0; b < 2; ++b)
#pragma unroll
                for (int m = 0; m < 4; ++m)
#pragma unroll
                    for (int n = 0; n < 2; ++n) acc[a][b][m][n] = (f32x4){0.f, 0.f, 0.f, 0.f};
        cur = nxt; cA = nA; cB = nB; ++ui;
        if constexpr (ALIGN_EPI) { if (wr == 1) PG8_BAR; }
    }
    PG8_WAIT_V(0);
    if constexpr (!ALIGN_EPI) { if (wr == 0) PG8_BAR; }
    PG8_BAR;
    if constexpr (Epi::AFTER_DRAIN) { E.fused(acc, cur, wr, wc, fr, fq, lds, wid, lane); S.done(cur); }
#undef PG8_SA
#undef PG8_SB
#undef PG8_STAGE
#undef PG8_LDA
#undef PG8_LDB
#undef PG8_MMA
#undef PG8_WAIT_V
#undef PG8_WAIT_L
#undef PG8_BAR
#undef PG8_SCHED
}
}

constexpr int NTOK = 8192, SEQ = 4096, DM = 2048, DC = 1024, DS = 1024, NIN = 3072;
constexpr int NMEMTOK = 512  , HD = 512;
constexpr int PE = 16384;
constexpr float EPS = 1e-6f;
constexpr int NTHREADS = 512, NWAVES = 8;
constexpr int LDS_BYTES = 147456;

#define LAS __attribute__((address_space(3)))
typedef unsigned short bf16;
typedef float f32x4 __attribute__((ext_vector_type(4)));
typedef float f32x2 __attribute__((ext_vector_type(2)));
typedef short bf16x8 __attribute__((ext_vector_type(8)));
typedef unsigned u32x4 __attribute__((ext_vector_type(4)));
typedef unsigned u32x2 __attribute__((ext_vector_type(2)));

constexpr size_t MiB = 1u << 20;
constexpr size_t WS_CTL = 0;
constexpr size_t WS_WIN = 1 * MiB, WS_WKV = 13 * MiB, WS_WGLU = 29 * MiB, WS_WOUT = 31 * MiB, WS_WQ = 39 * MiB, WS_WO = 47 * MiB, WS_WPQ = 55 * MiB;
constexpr size_t WS_KEYS = 59 * MiB;
constexpr size_t WS_PART1 = 60 * MiB, WS_PART2 = 61 * MiB, WS_PARTS = 62 * MiB;
constexpr size_t WS_UB = 64 * MiB, WS_VB = 96 * MiB;
constexpr size_t WS_QSC = 63 * MiB;
constexpr size_t WS_AB = 192 * MiB;
constexpr size_t WS_PROJ = 224 * MiB;
constexpr size_t WS_MEMN = 272 * MiB, WS_KV = 274 * MiB;
constexpr size_t WS_G = 224 * MiB;
constexpr size_t WS_HC = 232 * MiB;
constexpr size_t WS_P = 240 * MiB;
constexpr size_t WS_Z = 278 * MiB;
constexpr size_t WS_YS = 294 * MiB;
constexpr size_t WS_Y = 310 * MiB;
constexpr size_t WS_H = 342 * MiB;
constexpr size_t WS_S5E = 406 * MiB, WS_S5F = 410 * MiB, WS_S5K = 414 * MiB, WS_S5L = 415 * MiB;
constexpr size_t WS_PU = 128 * MiB;
constexpr size_t WS_WP = 416 * MiB;
constexpr size_t WS_WSUM = 420 * MiB;
constexpr size_t WS_PARTF = 421 * MiB;
constexpr size_t WS_END = 422 * MiB;
constexpr int CW_CONVQ = 4096;

struct Args {
    const float* in[31];
    float* out;
    unsigned char* ws;
};

__device__ __forceinline__ unsigned f2bf(float f) { unsigned u = __builtin_bit_cast(unsigned, f); return (u + 0x7fffu + ((u >> 16) & 1u)) >> 16; }
__device__ __forceinline__ unsigned pk2(float lo, float hi) { return f2bf(lo) | (f2bf(hi) << 16); }
__device__ __forceinline__ float bflo(unsigned w) { return __builtin_bit_cast(float, w << 16); }
__device__ __forceinline__ float bfhi(unsigned w) { return __builtin_bit_cast(float, w & 0xffff0000u); }
__device__ __forceinline__ float bf2f(bf16 b) { return __builtin_bit_cast(float, (unsigned)b << 16); }
__device__ __forceinline__ float sigmoidf_(float x) { return 1.0f / (1.0f + __expf(-x)); }
__device__ __forceinline__ float gelu_tanh(float x) { const float u = 1.5957691216057308f * (x + 0.044715f * x * x * x); return x / (1.0f + __expf(-u)); }
__device__ __forceinline__ float wave_sum(float v) {
#pragma unroll
    for (int o = 1; o < 64; o <<= 1) v += __shfl_xor(v, o);
    return v;
}
__device__ __forceinline__ unsigned wave_umax(unsigned v) {
#pragma unroll
    for (int o = 1; o < 64; o <<= 1) { const unsigned t = (unsigned)__shfl_xor((int)v, o); v = t > v ? t : v; }
    return v;
}

template <int MODE, bool MIDK_ = false> struct Epi {
    static constexpr bool PERM = true, AFTER_DRAIN = false, MIDK = MIDK_;
    const float* mpart;
    LAS unsigned char* mlds;
    bf16* ob; int ldo; float cs;
    const float* rpart; int rnp;
    const bf16* zin;
    const float* hin; float* hout;
    float* wpart; int wnp;
    __device__ __forceinline__ void midk(pg8::f32x4 (&acc)[2][2][4][2], const pg8::Unit& u, int wr, int wc, int fr, int fq) const {
        const LAS float* rt = (const LAS float*)mlds;
#pragma unroll
        for (int ai = 0; ai < 2; ++ai)
#pragma unroll
            for (int m = 0; m < 4; ++m) {
                const float r = rt[ai * 128 + wr * 64 + m * 16 + fr];
#pragma unroll
                for (int bj = 0; bj < 2; ++bj) { acc[ai][bj][m][0] = acc[ai][bj][m][0] * r; acc[ai][bj][m][1] = acc[ai][bj][m][1] * r; }
            }
    }
    __device__ __forceinline__ void operator()(const pg8::f32x4 (&acc)[2][2][4][2], const pg8::Unit& u, int wr, int wc, int fr, int fq) const {
#pragma unroll
        for (int ai = 0; ai < 2; ++ai)
#pragma unroll
            for (int m = 0; m < 4; ++m) {
                const int row = u.pm * 256 + ai * 128 + wr * 64 + m * 16 + fr;
                float sc = cs;
                if (MODE == 0 && rpart) {
                    float s = 0.f;
                    for (int i = 0; i < rnp; i += 4) { const f32x4 v = *(const f32x4*)(rpart + (size_t)row * rnp + i); s += (v[0] + v[1]) + (v[2] + v[3]); }
                    sc *= 1.0f / sqrtf(s * (1.0f / 2048.0f) + EPS);
                }
                float ss = 0.f;
#pragma unroll
                for (int bj = 0; bj < 2; ++bj) {
                    const int col0 = u.pn * 256 + bj * 128 + wc * 32 + 8 * fq;
                    f32x4 v0 = acc[ai][bj][m][0], v1 = acc[ai][bj][m][1];
                    if (MODE == 0) { v0 = v0 * sc; v1 = v1 * sc; }
                    if (MODE == 1) {
                        const u32x4 zw = *(const u32x4*)(zin + (size_t)row * 1024 + col0);
                        v0[0] = bflo(zw[0]) * sigmoidf_(v0[0]); v0[1] = bfhi(zw[0]) * sigmoidf_(v0[1]); v0[2] = bflo(zw[1]) * sigmoidf_(v0[2]); v0[3] = bfhi(zw[1]) * sigmoidf_(v0[3]);
                        v1[0] = bflo(zw[2]) * sigmoidf_(v1[0]); v1[1] = bfhi(zw[2]) * sigmoidf_(v1[1]); v1[2] = bflo(zw[3]) * sigmoidf_(v1[2]); v1[3] = bfhi(zw[3]) * sigmoidf_(v1[3]);
                    }
                    if (MODE == 2) {
                        if (hin) {
                            const f32x4 h0 = *(const f32x4*)(hin + (size_t)row * 2048 + col0), h1 = *(const f32x4*)(hin + (size_t)row * 2048 + col0 + 4);
                            v0 = v0 + h0; v1 = v1 + h1;
                        } else {
                            const u32x4 hw = *(const u32x4*)(zin + (size_t)row * 2048 + col0);
                            v0[0] += bflo(hw[0]); v0[1] += bfhi(hw[0]); v0[2] += bflo(hw[1]); v0[3] += bfhi(hw[1]);
                            v1[0] += bflo(hw[2]); v1[1] += bfhi(hw[2]); v1[2] += bflo(hw[3]); v1[3] += bfhi(hw[3]);
                        }
                    }
                    if (MODE != 0) ss += (v0[0] * v0[0] + v0[1] * v0[1]) + (v0[2] * v0[2] + v0[3] * v0[3]) + (v1[0] * v1[0] + v1[1] * v1[1]) + (v1[2] * v1[2] + v1[3] * v1[3]);
                    u32x4 w; w[0] = pk2(v0[0], v0[1]); w[1] = pk2(v0[2], v0[3]); w[2] = pk2(v1[0], v1[1]); w[3] = pk2(v1[2], v1[3]);
                    *(u32x4*)(ob + (size_t)row * ldo + col0) = w;
                }
                if (MODE != 0) {
                    ss += __shfl_xor(ss, 16); ss += __shfl_xor(ss, 32);
                    if (fq == 0) wpart[(size_t)row * wnp + u.pn * 4 + wc] = ss;
                }
            }
    }
};

struct EpiSoftmax {
    static constexpr bool PERM = true, AFTER_DRAIN = true, MIDK = false;
    bf16* P; int ldp; const float* rpart; float cs;
    __device__ __forceinline__ void fused(pg8::f32x4 (&acc)[2][2][4][2], const pg8::Unit& u, int wr, int wc, int fr, int fq, LAS unsigned char* lds, int wid, int lane) const {
        LAS float* exm = (LAS float*)lds;
        LAS float* exs = exm + 1024;
        float mloc[2][4];
#pragma unroll
        for (int ai = 0; ai < 2; ++ai)
#pragma unroll
            for (int m = 0; m < 4; ++m) {
                const int rl = ai * 128 + wr * 64 + m * 16 + fr, row = u.pm * 256 + rl;
                float s = 0.f;
#pragma unroll
                for (int i = 0; i < 32; i += 4) { const f32x4 v = *(const f32x4*)(rpart + (size_t)row * 32 + i); s += (v[0] + v[1]) + (v[2] + v[3]); }
                const float sc = cs / sqrtf(s * (1.0f / 2048.0f) + EPS);
                float mx = -3.0e38f;
#pragma unroll
                for (int bj = 0; bj < 2; ++bj)
#pragma unroll
                    for (int n = 0; n < 2; ++n) { acc[ai][bj][m][n] = acc[ai][bj][m][n] * sc; const f32x4 v = acc[ai][bj][m][n]; mx = fmaxf(mx, fmaxf(fmaxf(v[0], v[1]), fmaxf(v[2], v[3]))); }
                mx = fmaxf(mx, __shfl_xor(mx, 16)); mx = fmaxf(mx, __shfl_xor(mx, 32));
                if (fq == 0) exm[rl * 4 + wc] = mx;
            }
        __syncthreads();
#pragma unroll
        for (int ai = 0; ai < 2; ++ai)
#pragma unroll
            for (int m = 0; m < 4; ++m) {
                const int rl = ai * 128 + wr * 64 + m * 16 + fr;
                const f32x4 mv = *(const LAS f32x4*)(exm + rl * 4);
                const float mx = fmaxf(fmaxf(mv[0], mv[1]), fmaxf(mv[2], mv[3]));
                float sm = 0.f;
#pragma unroll
                for (int bj = 0; bj < 2; ++bj)
#pragma unroll
                    for (int n = 0; n < 2; ++n) {
                        f32x4 v = acc[ai][bj][m][n];
                        v[0] = __expf(v[0] - mx); v[1] = __expf(v[1] - mx); v[2] = __expf(v[2] - mx); v[3] = __expf(v[3] - mx);
                        acc[ai][bj][m][n] = v; sm += (v[0] + v[1]) + (v[2] + v[3]);
                    }
                sm += __shfl_xor(sm, 16); sm += __shfl_xor(sm, 32);
                if (fq == 0) exs[rl * 4 + wc] = sm;
                mloc[ai][m] = 0.f;
            }
        __syncthreads();
#pragma unroll
        for (int ai = 0; ai < 2; ++ai)
#pragma unroll
            for (int m = 0; m < 4; ++m) {
                const int rl = ai * 128 + wr * 64 + m * 16 + fr;
                const f32x4 sv = *(const LAS f32x4*)(exs + rl * 4);
                const float inv = 1.0f / ((sv[0] + sv[1]) + (sv[2] + sv[3]));
#pragma unroll
                for (int bj = 0; bj < 2; ++bj) {
                    const f32x4 v0 = acc[ai][bj][m][0] * inv, v1 = acc[ai][bj][m][1] * inv;
                    u32x4 w; w[0] = pk2(v0[0], v0[1]); w[1] = pk2(v0[2], v0[3]); w[2] = pk2(v1[0], v1[1]); w[3] = pk2(v1[2], v1[3]);
                    *(u32x4*)(P + (size_t)(u.pm * 256 + rl) * ldp + u.pn * 256 + bj * 128 + wc * 32 + 8 * fq) = w;
                }
            }
        (void)mloc; (void)wid; (void)lane;
        __syncthreads();
    }
};

template <class EPI, bool ALIGN = true> __device__ __forceinline__ void run_gemm(LAS unsigned char* lds, const bf16* A, const bf16* Bt, int M_, int N_, int K_, const EPI& E, int cshift = 0, int lda = 0, int ldb = 0) {
    pg8::Gemm g{A, Bt, M_, N_, K_, lda ? lda : K_, ldb ? ldb : K_}; pg8::StaticOrder S; S.init(M_, N_, (int)gridDim.x, (int)((blockIdx.x + gridDim.x - cshift) % gridDim.x));
    pg8::gemm_phase<EPI, pg8::StaticOrder, ALIGN, true>(lds, g, S, E);
}

__device__ __forceinline__ void quant_rows(const Args& a, int r0, int r1) {
    int tid_ = threadIdx.x; asm volatile("" : "+v"(tid_));
    const int tid = tid_, lane = tid & 63, wave = tid >> 6;
    unsigned char* ws = a.ws;
    const float* gf = a.in[25];
    unsigned char* Uq = ws + WS_UB; unsigned char* Vq = ws + WS_VB;
    float* su = (float*)(ws + WS_QSC); float* sv = su + PE;
#define QR_LOAD(v, r) do { const float* src_ = (((r) < PE) ? a.in[28] + (size_t)(r) * 2048 : a.in[29] + (size_t)((r) - PE) * 2048); \
        _Pragma("unroll") for (int j_ = 0; j_ < 8; ++j_) v[j_] = __builtin_nontemporal_load((const f32x4*)(src_ + 4 * (lane + 64 * j_))); } while (0)
#define QR_PROC(v, r) do { const bool isu_ = (r) < PE; const int e_ = isu_ ? (r) : (r) - PE; float mx_ = 0.f; \
        _Pragma("unroll") for (int j_ = 0; j_ < 8; ++j_) { if (isu_) v[j_] = v[j_] * *(const f32x4*)(gf + 4 * (lane + 64 * j_)); \
            mx_ = fmaxf(mx_, fmaxf(fmaxf(fabsf(v[j_][0]), fabsf(v[j_][1])), fmaxf(fabsf(v[j_][2]), fabsf(v[j_][3])))); } \
        _Pragma("unroll") for (int o_ = 1; o_ < 64; o_ <<= 1) mx_ = fmaxf(mx_, __shfl_xor(mx_, o_)); \
        mx_ = fmaxf(mx_, 1e-30f); const float inv_ = 127.0f / mx_; unsigned char* tab_ = isu_ ? Uq : Vq; \
        _Pragma("unroll") for (int j_ = 0; j_ < 8; ++j_) { unsigned w_ = 0u; \
            _Pragma("unroll") for (int k_ = 0; k_ < 4; ++k_) { const int q_ = (int)rintf(v[j_][k_] * inv_); w_ |= ((unsigned)q_ & 0xffu) << (8 * k_); } \
            __builtin_nontemporal_store(w_, (unsigned*)(tab_ + ((size_t)(2 * j_ + (lane >> 5)) * PE + e_) * 128 + 4 * (lane & 31))); } \
        if (lane == 0) (isu_ ? su : sv)[e_] = mx_ * (1.0f / 127.0f); } while (0)
    f32x4 va[8], vb[8];
    int r = r0 + wave;
    if (r < r1) QR_LOAD(va, r);
    for (; r < r1; r += 2 * NWAVES) {
        const int rn = r + NWAVES;
        if (rn < r1) QR_LOAD(vb, rn);
        QR_PROC(va, r);
        if (rn < r1) {
            if (rn + NWAVES < r1) QR_LOAD(va, rn + NWAVES);
            QR_PROC(vb, rn);
        }
    }
#undef QR_LOAD
#undef QR_PROC
}

__device__ __forceinline__ void p0_transpose_item(const float* W, int K, int N, bf16* WT, const float* sc0, const float* sc1, int ksplit, LAS float* scr, int item, int lane, int krot = 0) {
    const int nblk = N / 32, kb = item / nblk, nb = item % nblk, k0 = 64 * kb, n0 = 32 * nb;
    f32x4 v[8];
#pragma unroll
    for (int i = 0; i < 8; ++i) {
        const int kk = 8 * i + (lane >> 3), k = (k0 + kk + krot) & (K - 1);
        v[i] = __builtin_nontemporal_load((const f32x4*)(W + (size_t)k * N + n0 + 4 * (lane & 7)));
        if (sc0) v[i] = v[i] * ((k < ksplit) ? sc0[k] : sc1[k - ksplit]);
    }
#pragma unroll
    for (int i = 0; i < 8; ++i) {
        const int kk = 8 * i + (lane >> 3); LAS float* d = scr + kk * 33 + 4 * (lane & 7);
        d[0] = v[i][0]; d[1] = v[i][1]; d[2] = v[i][2]; d[3] = v[i][3];
    }
    asm volatile("s_waitcnt lgkmcnt(0)" ::: "memory");
    const int c = lane & 7;
#pragma unroll
    for (int j = 0; j < 4; ++j) {
        const int n = (lane >> 3) + 8 * j; const LAS float* s = scr + (8 * c) * 33 + n;
        u32x4 o; o[0] = pk2(s[0 * 33], s[1 * 33]); o[1] = pk2(s[2 * 33], s[3 * 33]); o[2] = pk2(s[4 * 33], s[5 * 33]); o[3] = pk2(s[6 * 33], s[7 * 33]);
        *(u32x4*)(WT + (size_t)(n0 + n) * K + k0 + 8 * c) = o;
    }
    asm volatile("s_waitcnt lgkmcnt(0)" ::: "memory");
}
#define RR_LOAD(v, m) do { const float* x_ = ((m) < NTOK) ? a.in[0] + (size_t)(m) * 2048 : a.in[1] + (size_t)((m) - NTOK) * 2048; \
        _Pragma("unroll") for (int j_ = 0; j_ < 8; ++j_) v[j_] = __builtin_nontemporal_load((const f32x4*)(x_ + 4 * (lane + 64 * j_))); } while (0)
#define RR_PROC(v, m) do { const float* gain_ = ((m) < NTOK) ? a.in[2] : a.in[21]; \
        bf16* o_ = ((m) < NTOK) ? (bf16*)(a.ws + WS_AB) + (size_t)(m) * 2048 : (bf16*)(a.ws + WS_MEMN) + (size_t)((m) - NTOK) * 2048; float s_ = 0.f; \
        _Pragma("unroll") for (int j_ = 0; j_ < 8; ++j_) s_ += (v[j_][0] * v[j_][0] + v[j_][1] * v[j_][1]) + (v[j_][2] * v[j_][2] + v[j_][3] * v[j_][3]); \
        const float rinv_ = 1.0f / sqrtf(wave_sum(s_) * (1.0f / 2048.0f) + EPS); \
        _Pragma("unroll") for (int j_ = 0; j_ < 8; ++j_) { const f32x4 g_ = *(const f32x4*)(gain_ + 4 * (lane + 64 * j_)); \
            u32x2 w_; w_[0] = pk2(v[j_][0] * rinv_ * g_[0], v[j_][1] * rinv_ * g_[1]); w_[1] = pk2(v[j_][2] * rinv_ * g_[2], v[j_][3] * rinv_ * g_[3]); \
            *(u32x2*)(o_ + 4 * (lane + 64 * j_)) = w_; } } while (0)
__device__ __forceinline__ void rms_rows_to_bf16(const Args& a, int m0, int step, int m1, int lane) {
    f32x4 va[8], vb[8];
    int m = m0;
    if (m < m1) RR_LOAD(va, m);
    for (; m < m1; m += 2 * step) {
        const int mn = m + step;
        if (mn < m1) RR_LOAD(vb, mn);
        RR_PROC(va, m);
        if (mn < m1) {
            if (mn + step < m1) RR_LOAD(va, mn + step);
            RR_PROC(vb, mn);
        }
    }
}
__device__ __forceinline__ void s5_tables(const Args& a, LAS unsigned char* lds, int g, int part);
__device__ __forceinline__ void ph_prologue(const Args& a, LAS unsigned char* lds) {
    int tid_ = threadIdx.x; asm volatile("" : "+v"(tid_));
    const int tid = tid_, lane = tid & 63, wave = tid >> 6;
    const int gw = blockIdx.x * NWAVES + wave, NGW = gridDim.x * NWAVES;
    LAS float* scr = (LAS float*)(lds + wave * 16384);
    unsigned char* ws = a.ws;
    for (int j = blockIdx.x; j < 256; j += gridDim.x) s5_tables(a, lds, j >> 2, j & 3);
    constexpr int I_IN = 32 * 96, I_KV = 32 * 128, I_GLU = 16 * 32, I_OUT = 32 * 64, I_O = 32 * 64, I_PQ = 32 * 32;
    constexpr int NIT = I_IN + I_KV + I_GLU + I_OUT + I_O + I_PQ;
    for (int it = gw; it < NIT; it += NGW) {
        int r = it;
        if (r < I_IN) { p0_transpose_item(a.in[3], 2048, 3072, (bf16*)(ws + WS_WIN), nullptr, nullptr, 0, scr, r, lane); continue; } r -= I_IN;
        if (r < I_KV) { p0_transpose_item(a.in[23], 2048, 4096, (bf16*)(ws + WS_WKV), nullptr, nullptr, 0, scr, r, lane); continue; } r -= I_KV;
        if (r < I_GLU) { p0_transpose_item(a.in[16], 1024, 1024, (bf16*)(ws + WS_WGLU), nullptr, nullptr, 0, scr, r, lane); continue; } r -= I_GLU;
        if (r < I_OUT) { p0_transpose_item(a.in[19], 2048, 2048, (bf16*)(ws + WS_WOUT), a.in[17], a.in[18], 1024, scr, r, lane, 1024); continue; } r -= I_OUT;
        if (r < I_O) { p0_transpose_item(a.in[24], 2048, 2048, (bf16*)(ws + WS_WO), nullptr, nullptr, 0, scr, r, lane); continue; } r -= I_O;
        p0_transpose_item(a.in[26], 2048, 1024, (bf16*)(ws + WS_WPQ), a.in[25], a.in[25], 2048, scr, r, lane);
    }
    rms_rows_to_bf16(a, gw, NGW, NTOK + NMEMTOK, lane);
    const size_t gt = (size_t)blockIdx.x * NTHREADS + tid, NGT = (size_t)gridDim.x * NTHREADS;
    for (size_t i = gt; i < (size_t)2048 * 2048 / 8; i += NGT) {
        const float gk = a.in[20][(i * 8) >> 11];
        const f32x4 w0 = __builtin_nontemporal_load((const f32x4*)(a.in[22] + i * 8)), w1 = __builtin_nontemporal_load((const f32x4*)(a.in[22] + i * 8 + 4));
        u32x4 o; o[0] = pk2(w0[0] * gk, w0[1] * gk); o[1] = pk2(w0[2] * gk, w0[3] * gk); o[2] = pk2(w1[0] * gk, w1[1] * gk); o[3] = pk2(w1[2] * gk, w1[3] * gk);
        *(u32x4*)((bf16*)(ws + WS_WQ) + i * 8) = o;
    }
    for (size_t i = gt; i < (size_t)(16 * 128 * 64) / 8; i += NGT) {
        const f32x4 k0 = *(const f32x4*)(a.in[27] + i * 8), k1 = *(const f32x4*)(a.in[27] + i * 8 + 4);
        u32x4 o; o[0] = pk2(k0[0], k0[1]); o[1] = pk2(k0[2], k0[3]); o[2] = pk2(k1[0], k1[1]); o[3] = pk2(k1[2], k1[3]);
        *(u32x4*)((bf16*)(ws + WS_KEYS) + i * 8) = o;
    }
}

struct ConvState { f32x2 w[31], acc[31]; unsigned pa[16], pg[16]; f32x2 b; };
__device__ __forceinline__ void conv_norm_row(LAS float* co, const float* lng, const float* lnb, bf16* yr, int wave, int lane) {
    f32x4 v[4]; float s = 0.f;
#pragma unroll
    for (int i = 0; i < 4; ++i) { v[i] = *(LAS f32x4*)(co + wave * 1024 + 4 * (lane + 64 * i)); s += (v[i][0] + v[i][1]) + (v[i][2] + v[i][3]); }
    const float mean = wave_sum(s) * (1.0f / 1024.0f); float q = 0.f;
#pragma unroll
    for (int i = 0; i < 4; ++i) { v[i] = v[i] - mean; q += (v[i][0] * v[i][0] + v[i][1] * v[i][1]) + (v[i][2] * v[i][2] + v[i][3] * v[i][3]); }
    const float rstd = 1.0f / sqrtf(wave_sum(q) * (1.0f / 1024.0f) + EPS); float ss = 0.f;
#pragma unroll
    for (int i = 0; i < 4; ++i) {
        const f32x4 g = *(const f32x4*)(lng + 4 * (lane + 64 * i)), bb = *(const f32x4*)(lnb + 4 * (lane + 64 * i));
#pragma unroll
        for (int e = 0; e < 4; ++e) { const float y = v[i][e] * rstd * g[e] + bb[e]; const float sw = y * sigmoidf_(y); v[i][e] = sw; ss += sw * sw; }
    }
    const float rinv = 1.0f / sqrtf(wave_sum(ss) * (1.0f / 1024.0f) + EPS);
#pragma unroll
    for (int i = 0; i < 4; ++i) { u32x2 o; o[0] = pk2(v[i][0] * rinv, v[i][1] * rinv); o[1] = pk2(v[i][2] * rinv, v[i][3] * rinv); *(u32x2*)(yr + 4 * (lane + 64 * i)) = o; }
}
constexpr int CONV_T = 64, CONV_STEPS = CONV_T + 30, CONV_RING = 16;
template <int TAU> struct ConvStep {
    static __device__ __forceinline__ void run(ConvState& S, const bf16* pbase, int tl0, LAS float* co, const float* lng, const float* lnb, bf16* Y, int t0, int tid, int wave, int lane) {
        __builtin_amdgcn_sched_barrier(0);
        const unsigned av = S.pa[TAU % CONV_RING], gv = S.pg[TAU % CONV_RING];
        if constexpr (TAU + CONV_RING < CONV_STEPS) {
            if constexpr (TAU + CONV_RING < 30) {
                const int tl = tl0 - 30 + TAU + CONV_RING, tlc = tl < 0 ? 0 : tl;
                const unsigned va = *(const unsigned*)(pbase + (size_t)tlc * NIN), vg = *(const unsigned*)(pbase + (size_t)tlc * NIN + 1024);
                S.pa[TAU % CONV_RING] = tl < 0 ? 0u : va; S.pg[TAU % CONV_RING] = vg;
            } else {
                const bf16* pp = pbase + (size_t)(tl0 + (TAU + CONV_RING - 30)) * NIN;
                S.pa[TAU % CONV_RING] = *(const unsigned*)pp; S.pg[TAU % CONV_RING] = *(const unsigned*)(pp + 1024);
            }
        }
        const f32x2 x = (f32x2){bflo(av) * sigmoidf_(bflo(gv)), bfhi(av) * sigmoidf_(bfhi(gv))};
#pragma unroll
        for (int j = 0; j < 31; ++j) S.acc[(TAU + j) % 31] = __builtin_elementwise_fma(S.w[30 - j], x, S.acc[(TAU + j) % 31]);
        constexpr int sl = TAU % 31;
        if constexpr (TAU >= 30) {
            constexpr int row = (TAU - 30) & 7;
            *(LAS f32x2*)(co + row * 1024 + 2 * tid) = S.acc[sl];
            if constexpr (row == 7) {
                __syncthreads();
                conv_norm_row(co, lng, lnb, Y + (size_t)(t0 + (TAU - 37) + wave) * 2048 + 1024, wave, lane);
                __syncthreads();
            }
        }
        S.acc[sl] = S.b;
        ConvStep<TAU + 1>::run(S, pbase, tl0, co, lng, lnb, Y, t0, tid, wave, lane);
    }
};
template <> struct ConvStep<CONV_STEPS> {
    static __device__ __forceinline__ void run(ConvState&, const bf16*, int, LAS float*, const float*, const float*, bf16*, int, int, int, int) {}
};
__device__ __forceinline__ void ph_conv(const Args& a, LAS unsigned char* lds) {
    int tid_ = threadIdx.x; asm volatile("" : "+v"(tid_));
    const int tid = tid_, lane = tid & 63, wave = tid >> 6;
    const bf16* proj = (const bf16*)(a.ws + WS_PROJ);
    bf16* Y = (bf16*)(a.ws + WS_Y);
    LAS float* co = (LAS float*)lds;
    const float* cw = a.in[4]; const float* cb = a.in[5]; const float* lng = a.in[6]; const float* lnb = a.in[7];
    if (blockIdx.x < 128) return;
    ConvState S;
#pragma unroll
    for (int k = 0; k < 31; ++k) S.w[k] = *(const f32x2*)(cw + k * 1024 + 2 * tid);
    S.b = *(const f32x2*)(cb + 2 * tid);
    for (int item = (int)blockIdx.x - 128; item < NTOK / CONV_T; item += 128) {
        const int t0 = item * CONV_T, b = t0 / SEQ, tl0 = t0 % SEQ;
        const bf16* pbase = proj + (size_t)(b * SEQ) * NIN + 2 * tid;
#pragma unroll
        for (int s = 0; s < 31; ++s) S.acc[s] = S.b;
#pragma unroll
        for (int d = 0; d < CONV_RING; ++d) {
            const int tl = tl0 - 30 + d, tlc = tl < 0 ? 0 : tl;
            const unsigned va = *(const unsigned*)(pbase + (size_t)tlc * NIN), vg = *(const unsigned*)(pbase + (size_t)tlc * NIN + 1024);
            S.pa[d] = tl < 0 ? 0u : va; S.pg[d] = vg;
        }
        ConvStep<0>::run(S, pbase, tl0, co, lng, lnb, Y, t0, tid, wave, lane);
    }
}

__device__ __forceinline__ void s5_tables(const Args& a, LAS unsigned char* lds, int g, int part) {
    int tid_ = threadIdx.x; asm volatile("" : "+v"(tid_));
    const int tid = tid_;
    LAS float* pwr = (LAS float*)lds;
    LAS float* pwi = pwr + 17 * 64;
    LAS float* bbr = pwi + 17 * 64;
    LAS float* bbi = bbr + 1024;
    LAS float* cr = bbi + 1024;
    LAS float* ci = cr + 1024;
    const float dt = __expf(a.in[10][g]);
    for (int e = tid; e < 17 * 64; e += NTHREADS) {
        const int n = e >> 6, p = e & 63;
        const float lre = a.in[8][g * 64 + p], lim = a.in[9][g * 64 + p];
        const float er = expf((float)n * lre * dt); float sn, cs; sincosf((float)n * lim * dt, &sn, &cs); pwr[e] = er * cs; pwi[e] = er * sn;
    }
    for (int e = tid; e < 1024; e += NTHREADS) {
        const int p = e >> 4, h = e & 15;
        const float lre = a.in[8][g * 64 + p], lim = a.in[9][g * 64 + p];
        const float er = expf(lre * dt); float sn, cs; sincosf(lim * dt, &sn, &cs);
        const float x = er * cs - 1.0f, y = er * sn, den = 1.0f / (lre * lre + lim * lim);
        const float fr = (x * lre + y * lim) * den, fi = (y * lre - x * lim) * den;
        const float br = a.in[11][((size_t)g * 64 + p) * 16 + h], bi = a.in[12][((size_t)g * 64 + p) * 16 + h];
        bbr[e] = fr * br - fi * bi; bbi[e] = fr * bi + fi * br;
        cr[e] = a.in[13][(size_t)g * 1024 + e]; ci[e] = a.in[14][(size_t)g * 1024 + e];
    }
    __syncthreads();
    bf16* E = (bf16*)(a.ws + WS_S5E) + (size_t)g * 32768;
    bf16* F = (bf16*)(a.ws + WS_S5F) + (size_t)g * 32768;
    bf16* K16 = (bf16*)(a.ws + WS_S5K) + (size_t)g * 4096;
    float* L16 = (float*)(a.ws + WS_S5L) + (size_t)g * 128;
    for (int e2 = part * 4096 + tid; e2 < part * 4096 + 4096; e2 += NTHREADS) {
        const int row = e2 >> 7, col = (e2 & 127) * 2, c2 = row >> 6, p = row & 63, j = col >> 4, h0 = col & 15;
        const float pr = pwr[(15 - j) * 64 + p], pi = pwi[(15 - j) * 64 + p];
        float v[2];
#pragma unroll
        for (int t = 0; t < 2; ++t) { const float br = bbr[p * 16 + h0 + t], bi = bbi[p * 16 + h0 + t]; v[t] = c2 ? (pr * bi + pi * br) : (pr * br - pi * bi); }
        *(unsigned*)(E + (size_t)row * 256 + col) = pk2(v[0], v[1]);
    }
    for (int e2 = part * 4096 + tid; e2 < part * 4096 + 4096; e2 += NTHREADS) {
        const int row = e2 >> 6, col = (e2 & 63) * 2, r = row >> 4, h = row & 15, c2 = col >> 6, p0 = col & 63;
        float v[2];
#pragma unroll
        for (int t = 0; t < 2; ++t) {
            const int p = p0 + t; const float pr = pwr[(r + 1) * 64 + p], pi = pwi[(r + 1) * 64 + p], xr = cr[h * 64 + p], xi = ci[h * 64 + p];
            v[t] = c2 ? -(xr * pi + xi * pr) : (xr * pr - xi * pi);
        }
        *(unsigned*)(F + (size_t)row * 128 + col) = pk2(v[0], v[1]);
    }
    {
        const int e2 = part * 512 + tid;
        const int tau = e2 >> 7, h = (e2 >> 3) & 15, hp0 = (e2 & 7) * 2;
        float s0 = 0.f, s1 = 0.f;
        for (int p = 0; p < 64; ++p) {
            const float pr = pwr[tau * 64 + p], pi = pwi[tau * 64 + p], xr = cr[h * 64 + p], xi = ci[h * 64 + p];
            const float wr = xr * pr - xi * pi, wi = xr * pi + xi * pr;
            s0 += wr * bbr[p * 16 + hp0] - wi * bbi[p * 16 + hp0]; s1 += wr * bbr[p * 16 + hp0 + 1] - wi * bbi[p * 16 + hp0 + 1];
        }
        *(unsigned*)(K16 + (size_t)(tau * 16 + h) * 16 + hp0) = pk2(s0, s1);
    }
    if (part == 0 && tid < 64) { L16[tid] = pwr[16 * 64 + tid]; L16[64 + tid] = pwi[16 * 64 + tid]; }
    __syncthreads();
}

__device__ __forceinline__ void ph_s5(const Args& a, LAS unsigned char* lds) {
    int tid_ = threadIdx.x; asm volatile("" : "+v"(tid_));
    const int tid = tid_, lane = tid & 63, wave = __builtin_amdgcn_readfirstlane(tid >> 6), l15 = lane & 15, s4 = lane >> 4;
    const bf16* proj = (const bf16*)(a.ws + WS_PROJ);
    bf16* Z = (bf16*)(a.ws + WS_Z);
    LAS float* lbuf = (LAS float*)(lds + 2 * 33792);
    LAS unsigned char* sb = lds + 2 * 33792 + 33280;
    for (int prob = blockIdx.x; prob < 128; prob += gridDim.x) {
        const int b = prob >> 6, g = prob & 63;
        const bf16* E = (const bf16*)(a.ws + WS_S5E) + (size_t)g * 32768;
        const bf16* F = (const bf16*)(a.ws + WS_S5F) + (size_t)g * 32768;
        const bf16* K16 = (const bf16*)(a.ws + WS_S5K) + (size_t)g * 4096;
        const float* L16 = (const float*)(a.ws + WS_S5L) + (size_t)g * 128;
        const float l16r = L16[lane], l16i = L16[64 + lane];
        const f32x4 dco = *(const f32x4*)(a.in[15] + g * 16 + 4 * s4);
        bf16x8 ef[8], ff[2][4], kf[2][8];
#pragma unroll
        for (int ks = 0; ks < 8; ++ks) ef[ks] = *(const bf16x8*)(E + (size_t)(16 * wave + l15) * 256 + 8 * s4 + 32 * ks);
#pragma unroll
        for (int rr = 0; rr < 2; ++rr) {
            const int r = wave + 8 * rr;
#pragma unroll
            for (int ks = 0; ks < 4; ++ks) ff[rr][ks] = *(const bf16x8*)(F + (size_t)(16 * r + l15) * 128 + 8 * s4 + 32 * ks);
#pragma unroll
            for (int q = 0; q < 8; ++q) if (rr == 1 || q < 4) {
                const int tau = r - (2 * q + (s4 >> 1)), tc = tau < 0 ? 0 : tau;
                const u32x4 kw = *(const u32x4*)(K16 + (size_t)(tc * 16 + l15) * 16 + 8 * (s4 & 1));
                kf[rr][q] = __builtin_bit_cast(bf16x8, tau < 0 ? (u32x4){0u, 0u, 0u, 0u} : kw);
            }
        }
        float Sr = 0.f, Si = 0.f;
        {
            const size_t segtok0 = (size_t)b * SEQ;
#pragma unroll
            for (int i = 0; i < 2; ++i) {
                const int t2 = tid + i * NTHREADS;
                const bf16* src = proj + (segtok0 + t2) * NIN + 2048 + g * 16;
                const u32x4 v0 = *(const u32x4*)src, v1 = *(const u32x4*)(src + 8);
                LAS unsigned char* dst = lds + (t2 >> 4) * 528 + (t2 & 15) * 32;
                *(LAS u32x4*)dst = v0; *(LAS u32x4*)(dst + 16) = v1;
            }
        }
        __syncthreads();
        for (int seg = 0; seg < 4; ++seg) {
            const size_t segtok0 = (size_t)b * SEQ + seg * 1024;
            LAS unsigned char* useg = lds + (seg & 1) * 33792;
            LAS unsigned char* unext = lds + ((seg + 1) & 1) * 33792;
            u32x4 pf[4];
            if (seg < 3) {
#pragma unroll
                for (int i = 0; i < 2; ++i) {
                    const int t2 = tid + i * NTHREADS;
                    const bf16* src = proj + (segtok0 + 1024 + t2) * NIN + 2048 + g * 16;
                    pf[2 * i] = *(const u32x4*)src; pf[2 * i + 1] = *(const u32x4*)(src + 8);
                }
            }
            {
                f32x4 acc[4];
#pragma unroll
                for (int nb = 0; nb < 4; ++nb) acc[nb] = (f32x4){0.f, 0.f, 0.f, 0.f};
#pragma unroll
                for (int ks = 0; ks < 8; ++ks) {
#pragma unroll
                    for (int nb = 0; nb < 4; ++nb) {
                        const bf16x8 uf = *(const LAS bf16x8*)(useg + (16 * nb + l15) * 528 + (2 * ks + (s4 >> 1)) * 32 + 16 * (s4 & 1));
                        acc[nb] = __builtin_amdgcn_mfma_f32_16x16x32_bf16(ef[ks], uf, acc[nb], 0, 0, 0);
                    }
                    if (ks & 1) __builtin_amdgcn_sched_barrier(0);
                }
#pragma unroll
                for (int nb = 0; nb < 4; ++nb)
#pragma unroll
                    for (int j = 0; j < 4; ++j) lbuf[(16 * wave + 4 * s4 + j) * 65 + 16 * nb + l15] = acc[nb][j];
            }
            __syncthreads();
            if (wave == 0) {
                LAS bf16* sb16 = (LAS bf16*)sb;
#pragma unroll 1
                for (int s8 = 0; s8 < 64; s8 += 8) {
                    float lr[8], li[8];
#pragma unroll
                    for (int k = 0; k < 8; ++k) { lr[k] = lbuf[lane * 65 + s8 + k]; li[k] = lbuf[(64 + lane) * 65 + s8 + k]; }
#pragma unroll
                    for (int k = 0; k < 8; ++k) {
                        sb16[(s8 + k) * 136 + lane] = (bf16)f2bf(Sr); sb16[(s8 + k) * 136 + 64 + lane] = (bf16)f2bf(Si);
                        const float nr = l16r * Sr - l16i * Si + lr[k], ni = l16r * Si + l16i * Sr + li[k];
                        Sr = nr; Si = ni;
                    }
                }
            }
            __syncthreads();
#pragma unroll
            for (int rr = 0; rr < 2; ++rr) {
                const int r = wave + 8 * rr;
                f32x4 acc[4];
#pragma unroll
                for (int nb = 0; nb < 4; ++nb) acc[nb] = (f32x4){0.f, 0.f, 0.f, 0.f};
#pragma unroll
                for (int ks = 0; ks < 4; ++ks) {
#pragma unroll
                    for (int nb = 0; nb < 4; ++nb) {
                        const bf16x8 sf = *(const LAS bf16x8*)(sb + (16 * nb + l15) * 272 + (32 * ks + 8 * s4) * 2);
                        acc[nb] = __builtin_amdgcn_mfma_f32_16x16x32_bf16(ff[rr][ks], sf, acc[nb], 0, 0, 0);
                    }
                    if (ks & 1) __builtin_amdgcn_sched_barrier(0);
                }
#pragma unroll
                for (int q = 0; q < 8; ++q) {
                    if ((rr == 1 || q < 4) && 2 * q <= r) {
#pragma unroll
                        for (int nb = 0; nb < 4; ++nb) {
                            const bf16x8 uf = *(const LAS bf16x8*)(useg + (16 * nb + l15) * 528 + (2 * q + (s4 >> 1)) * 32 + 16 * (s4 & 1));
                            acc[nb] = __builtin_amdgcn_mfma_f32_16x16x32_bf16(kf[rr][q], uf, acc[nb], 0, 0, 0);
                        }
                    }
                    if (q & 1) __builtin_amdgcn_sched_barrier(0);
                }
#pragma unroll
                for (int nb = 0; nb < 4; ++nb) {
                    const int sc = 16 * nb + l15;
                    const u32x2 uw = *(const LAS u32x2*)(useg + sc * 528 + r * 32 + 8 * s4);
                    const float y0 = acc[nb][0] + dco[0] * bflo(uw[0]), y1 = acc[nb][1] + dco[1] * bfhi(uw[0]), y2 = acc[nb][2] + dco[2] * bflo(uw[1]), y3 = acc[nb][3] + dco[3] * bfhi(uw[1]);
                    u32x2 o; o[0] = pk2(gelu_tanh(y0), gelu_tanh(y1)); o[1] = pk2(gelu_tanh(y2), gelu_tanh(y3));
                    *(u32x2*)(Z + (segtok0 + 16 * sc + r) * 1024 + g * 16 + 4 * s4) = o;
                }
            }
            if (seg < 3) {
#pragma unroll
                for (int i = 0; i < 2; ++i) {
                    const int t2 = tid + i * NTHREADS;
                    LAS unsigned char* dst = unext + (t2 >> 4) * 528 + (t2 & 15) * 32;
                    *(LAS u32x4*)dst = pf[2 * i]; *(LAS u32x4*)(dst + 16) = pf[2 * i + 1];
                }
            }
            __syncthreads();
        }
    }
}

__device__ __forceinline__ void ph_ysnorm(const Args& a) {
    int tid_ = threadIdx.x; asm volatile("" : "+v"(tid_));
    const int tid = tid_, lane = tid & 63, wave = tid >> 6;
    const int gw = blockIdx.x * NWAVES + wave, NGW = gridDim.x * NWAVES;
    const bf16* ys = (const bf16*)(a.ws + WS_YS); bf16* Y = (bf16*)(a.ws + WS_Y); const float* part = (const float*)(a.ws + WS_PARTS);
    for (int m = gw; m < NTOK; m += NGW) {
        float s = (lane < 16) ? part[(size_t)m * 16 + lane] : 0.f;
        const float rinv = 1.0f / sqrtf(wave_sum(s) * (1.0f / 1024.0f) + EPS);
#pragma unroll
        for (int j = 0; j < 2; ++j) {
            const u32x4 w = *(const u32x4*)(ys + (size_t)m * 1024 + 8 * (lane + 64 * j));
            u32x4 o;
#pragma unroll
            for (int e = 0; e < 4; ++e) o[e] = pk2(bflo(w[e]) * rinv, bfhi(w[e]) * rinv);
            *(u32x4*)(Y + (size_t)m * 2048 + 1024 + 8 * (lane + 64 * j)) = o;
        }
    }
}

__device__ __forceinline__ unsigned enc_key(float v) { const unsigned b = __builtin_bit_cast(unsigned, v); return b ^ ((b >> 31) ? 0xffffffffu : 0x80000000u); }
__device__ __forceinline__ float dec_key(unsigned o) { const unsigned b = (o & 0x80000000u) ? (o ^ 0x80000000u) : ~o; return __builtin_bit_cast(float, b); }
template <int CTRL> __device__ __forceinline__ unsigned dpp_u(unsigned v) { return (unsigned)__builtin_amdgcn_update_dpp(0, (int)v, CTRL, 0xf, 0xf, false); }
__device__ __forceinline__ unsigned row_umax(unsigned v) {
    unsigned t;
    t = dpp_u<0x128>(v); v = t > v ? t : v;
    t = dpp_u<0x124>(v); v = t > v ? t : v;
    t = dpp_u<0x122>(v); v = t > v ? t : v;
    t = dpp_u<0x121>(v); v = t > v ? t : v;
    return v;
}
#define CSWAP(x, y) do { const unsigned hi_ = (x) > (y) ? (x) : (y), lo_ = (x) > (y) ? (y) : (x); (x) = hi_; (y) = lo_; } while (0)
__device__ __forceinline__ void ph_topk(const Args& a, LAS unsigned char* lds) {
    int tid_ = threadIdx.x; asm volatile("" : "+v"(tid_));
    const int tid = tid_, lane = tid & 63, wave = tid >> 6, l15 = lane & 15, s4 = lane >> 4;
    const bf16* qp = (const bf16*)(a.ws + WS_Z);
    const bf16* keysb = (const bf16*)(a.ws + WS_KEYS);
    int* idxo = (int*)(a.ws + WS_YS); float* gateo = (float*)(a.ws + WS_YS + 4 * MiB);
    LAS float* sc = (LAS float*)lds;
    LAS unsigned* lst = (LAS unsigned*)(lds + 64 * 257 * 4) + wave * 128 + s4 * 32;
    for (int item = blockIdx.x; item < 128 * 8; item += gridDim.x) {
        const int h = item & 7, t0 = (item >> 3) * 64;
#pragma unroll
        for (int nn = 0; nn < 2; ++nn) {
            const int nb = 2 * wave + nn, side = nb >> 3, nbl = nb & 7;
            bf16x8 kf[2];
#pragma unroll
            for (int ks = 0; ks < 2; ++ks) kf[ks] = *(const bf16x8*)(keysb + ((size_t)((h * 2 + side) * 128 + 16 * nbl + l15)) * 64 + 32 * ks + 8 * s4);
#pragma unroll
            for (int mb = 0; mb < 4; ++mb) {
                f32x4 c = {0.f, 0.f, 0.f, 0.f};
#pragma unroll
                for (int ks = 0; ks < 2; ++ks) {
                    const bf16x8 qf = *(const bf16x8*)(qp + (size_t)(t0 + 16 * mb + l15) * 1024 + h * 128 + side * 64 + 32 * ks + 8 * s4);
                    c = __builtin_amdgcn_mfma_f32_16x16x32_bf16(qf, kf[ks], c, 0, 0, 0);
                }
#pragma unroll
                for (int j = 0; j < 4; ++j) sc[(16 * mb + 4 * s4 + j) * 257 + side * 128 + 16 * nbl + l15] = c[j];
            }
        }
        __syncthreads();
#pragma unroll 1
        for (int tt = 0; tt < 2; ++tt) {
            const int tl = wave * 8 + tt * 4 + s4; const LAS float* sr = sc + tl * 257;
            unsigned top[2];
#pragma unroll
            for (int side = 0; side < 2; ++side) {
                unsigned v[8];
#pragma unroll
                for (int k = 0; k < 8; ++k) v[k] = (enc_key(sr[side * 128 + l15 + 16 * k]) & ~127u) | (unsigned)(127 - (l15 + 16 * k));
                CSWAP(v[0], v[1]); CSWAP(v[2], v[3]); CSWAP(v[4], v[5]); CSWAP(v[6], v[7]);
                CSWAP(v[0], v[2]); CSWAP(v[1], v[3]); CSWAP(v[4], v[6]); CSWAP(v[5], v[7]);
                CSWAP(v[1], v[2]); CSWAP(v[5], v[6]); CSWAP(v[0], v[4]); CSWAP(v[3], v[7]);
                CSWAP(v[1], v[5]); CSWAP(v[2], v[6]);
                CSWAP(v[1], v[4]); CSWAP(v[3], v[6]);
                CSWAP(v[2], v[4]); CSWAP(v[3], v[5]);
                CSWAP(v[3], v[4]);
                unsigned mine = 0u;
#pragma unroll
                for (int it = 0; it < 16; ++it) {
                    const unsigned m = row_umax(v[0]);
                    const bool win = v[0] == m;
#pragma unroll
                    for (int k = 0; k < 7; ++k) v[k] = win ? v[k + 1] : v[k];
                    v[7] = win ? 0u : v[7];
                    mine = (l15 == it) ? m : mine;
                }
                top[side] = mine;
            }
            lst[l15] = top[0]; lst[16 + l15] = top[1];
            asm volatile("s_waitcnt lgkmcnt(0)" ::: "memory");
            const float s1 = dec_key(top[0] & ~127u);
            unsigned c[16];
#pragma unroll
            for (int q = 0; q < 4; ++q) {
                const u32x4 w = *(const LAS u32x4*)(lst + 16 + 4 * q);
#pragma unroll
                for (int k = 0; k < 4; ++k) c[4 * q + k] = (enc_key(s1 + dec_key(w[k] & ~127u)) & ~255u) | (unsigned)(255 - (l15 * 16 + 4 * q + k));
            }
            unsigned mine = 0u;
#pragma unroll
            for (int it = 0; it < 16; ++it) {
                const unsigned m = row_umax(c[0]);
                const bool win = c[0] == m;
#pragma unroll
                for (int k = 0; k < 15; ++k) c[k] = win ? c[k + 1] : c[k];
                c[15] = win ? 0u : c[15];
                mine = (l15 == it) ? m : mine;
            }
            const float val = dec_key(mine & ~255u);
            float vm = val;
            { float t;
              t = __builtin_bit_cast(float, dpp_u<0x128>(__builtin_bit_cast(unsigned, vm))); vm = fmaxf(vm, t);
              t = __builtin_bit_cast(float, dpp_u<0x124>(__builtin_bit_cast(unsigned, vm))); vm = fmaxf(vm, t);
              t = __builtin_bit_cast(float, dpp_u<0x122>(__builtin_bit_cast(unsigned, vm))); vm = fmaxf(vm, t);
              t = __builtin_bit_cast(float, dpp_u<0x121>(__builtin_bit_cast(unsigned, vm))); vm = fmaxf(vm, t); }
            const float ex = __expf(val - vm);
            float sm = ex;
            { float t;
              t = __builtin_bit_cast(float, dpp_u<0x128>(__builtin_bit_cast(unsigned, sm))); sm += t;
              t = __builtin_bit_cast(float, dpp_u<0x124>(__builtin_bit_cast(unsigned, sm))); sm += t;
              t = __builtin_bit_cast(float, dpp_u<0x122>(__builtin_bit_cast(unsigned, sm))); sm += t;
              t = __builtin_bit_cast(float, dpp_u<0x121>(__builtin_bit_cast(unsigned, sm))); sm += t; }
            {
                const int cand = 255 - (int)(mine & 255u), ia = cand >> 4, ib = cand & 15;
                const int i1 = 127 - (int)(lst[ia] & 127u), i2 = 127 - (int)(lst[16 + ib] & 127u);
                const int jp = h * 16 + l15;
                const size_t o = (size_t)(t0 + tl) * 128 + (jp & 7) * 16 + (jp >> 3);
                idxo[o] = i1 * 128 + i2; gateo[o] = ex / sm;
            }
            asm volatile("s_waitcnt lgkmcnt(0)" ::: "memory");
        }
        __syncthreads();
    }
}

__device__ __forceinline__ float cvt_ub(unsigned w, int k) { return (float)((w >> (8 * k)) & 0xffu); }
template <int CTRL> __device__ __forceinline__ float dpp_f(float v) { return __builtin_bit_cast(float, __builtin_amdgcn_update_dpp(0, __builtin_bit_cast(int, v), CTRL, 0xf, 0xf, false)); }
#define PP_LOAD_IDX(ei, tok) do { _Pragma("unroll") for (int q_ = 0; q_ < 4; ++q_) { const u32x4 t_ = *(const u32x4*)(idx + (size_t)(tok) * 128 + pr * 16 + 4 * q_); \
        ei[4 * q_] = (int)t_[0]; ei[4 * q_ + 1] = (int)t_[1]; ei[4 * q_ + 2] = (int)t_[2]; ei[4 * q_ + 3] = (int)t_[3]; } } while (0)
#define PP_G8(ub, ei, o8) do { _Pragma("unroll") for (int i_ = 0; i_ < 8; ++i_) ub[i_] = *(const u32x4*)(slab + ((unsigned)ei[(o8) + i_] * 128u + coff)); } while (0)
#define PU_LOAD_H(hx, tok) do { hx[0] = *(const u32x4*)(h2b + (size_t)(tok) * 2048 + 128 * s + 16 * c); hx[1] = *(const u32x4*)(h2b + (size_t)(tok) * 2048 + 128 * s + 16 * c + 8); } while (0)
template <int CTRL> __device__ __forceinline__ int dpp_i(int v) { return __builtin_amdgcn_update_dpp(0, v, CTRL, 0xf, 0xf, false); }
#define PU_QUANT(hx, hq, hs) do { \
        float f_[16]; _Pragma("unroll") for (int q_ = 0; q_ < 2; ++q_) _Pragma("unroll") for (int e_ = 0; e_ < 4; ++e_) { f_[8 * q_ + 2 * e_] = bflo(hx[q_][e_]); f_[8 * q_ + 2 * e_ + 1] = bfhi(hx[q_][e_]); } \
        float m_ = 0.f; _Pragma("unroll") for (int k_ = 0; k_ < 16; ++k_) m_ = fmaxf(m_, fabsf(f_[k_])); \
        m_ = fmaxf(m_, dpp_f<0xB1>(m_)); m_ = fmaxf(m_, dpp_f<0x4E>(m_)); m_ = fmaxf(m_, dpp_f<0x141>(m_)); m_ = fmaxf(m_, 1e-30f); \
        const float iv_ = 127.0f / m_; hs = m_ * (1.0f / 127.0f); \
        _Pragma("unroll") for (int q_ = 0; q_ < 4; ++q_) { \
            const int a0_ = (int)rintf(f_[4 * q_] * iv_), a1_ = (int)rintf(f_[4 * q_ + 1] * iv_), a2_ = (int)rintf(f_[4 * q_ + 2] * iv_), a3_ = (int)rintf(f_[4 * q_ + 3] * iv_); \
            hq[q_] = (int)(((unsigned)a0_ & 0xffu) | (((unsigned)a1_ & 0xffu) << 8) | (((unsigned)a2_ & 0xffu) << 16) | ((unsigned)a3_ << 24)); } } while (0)
#define PU_C8(ub, hq, hs, res) do { \
        _Pragma("unroll") for (int i_ = 0; i_ < 8; ++i_) { \
            int d_ = 0; \
            _Pragma("unroll") for (int q_ = 0; q_ < 4; ++q_) d_ = __builtin_amdgcn_sdot4((int)ub[i_][q_], hq[q_], d_, false); \
            d_ += dpp_i<0xB1>(d_); d_ += dpp_i<0x4E>(d_); d_ += dpp_i<0x141>(d_); \
            res = (c == i_) ? (float)d_ * hs : res; } } while (0)
#define PU_STORE(tok, r0, r1) do { float* po_ = pu + ((size_t)s * NTOK + (tok)) * 128 + pr * 16 + c; po_[0] = r0; po_[8] = r1; } while (0)
__device__ __forceinline__ void ph_peer_u(const Args& a) {
    int tid_ = threadIdx.x; asm volatile("" : "+v"(tid_));
    const int tid = tid_, lane = tid & 63, wave = tid >> 6, pr = lane >> 3, c = lane & 7;
    const bf16* h2b = (const bf16*)(a.ws + WS_AB);
    const unsigned char* Uq = a.ws + WS_UB;
    const int* idx = (const int*)(a.ws + WS_YS);
    float* pu = (float*)(a.ws + WS_PU);
    const int x = blockIdx.x & 7, nbx = gridDim.x >> 3, bi = blockIdx.x >> 3;
    const int tstride = nbx * NWAVES, tfirst = bi * NWAVES + wave, ntok = NTOK / tstride;
    const unsigned coff = 16u * (unsigned)c;
    for (int pass = 0; pass < 2; ++pass) {
        const int s = x + 8 * pass;
        const unsigned char* slab = Uq + (size_t)s * PE * 128;
        int eA[16], eB[16]; u32x4 ub0[8], ub1[8]; u32x4 hA[2], hB[2];
        PP_LOAD_IDX(eA, tfirst);
        PP_G8(ub0, eA, 0); PU_LOAD_H(hA, tfirst);
        PP_LOAD_IDX(eB, tfirst + tstride);
        for (int k = 0; k < ntok; k += 2) {
            const int tokA = tfirst + k * tstride, tokB = tokA + tstride;
            const bool more = k + 2 < ntok;
            float r0 = 0.f, r1 = 0.f; int hq[4]; float hs;
            PP_G8(ub1, eA, 8);
            if (more) PP_LOAD_IDX(eA, tokA + 2 * tstride);
            PU_QUANT(hA, hq, hs);
            PU_C8(ub0, hq, hs, r0);
            PP_G8(ub0, eB, 0); PU_LOAD_H(hB, tokB);
            PU_C8(ub1, hq, hs, r1);
            PU_STORE(tokA, r0, r1);
            r0 = 0.f; r1 = 0.f;
            PP_G8(ub1, eB, 8);
            if (more) PP_LOAD_IDX(eB, tokB + 2 * tstride);
            PU_QUANT(hB, hq, hs);
            PU_C8(ub0, hq, hs, r0);
            if (more) { PP_G8(ub0, eA, 0); PU_LOAD_H(hA, tokA + 2 * tstride); }
            PU_C8(ub1, hq, hs, r1);
            PU_STORE(tokB, r0, r1);
        }
    }
}
__device__ __forceinline__ void ph_peer_w(const Args& a) {
    int tid_ = threadIdx.x; asm volatile("" : "+v"(tid_));
    const int tid = tid_, lane = tid & 63, wave = tid >> 6;
    const float* part = (const float*)(a.ws + WS_PART2);
    const float* su = (const float*)(a.ws + WS_QSC); const float* sv = su + PE;
    const int* idx = (const int*)(a.ws + WS_YS); const float* gate = (const float*)(a.ws + WS_YS + 4 * MiB);
    const float* pu = (const float*)(a.ws + WS_PU);
    unsigned char* wq = (unsigned char*)(a.ws + WS_WP); float* wsc = (float*)(a.ws + WS_WSUM);
    for (int tok = blockIdx.x * NWAVES + wave; tok < NTOK; tok += gridDim.x * NWAVES) {
        const float ps = (lane < 32) ? part[(size_t)tok * 32 + lane] : 0.f;
        const float rinv = 1.0f / sqrtf(wave_sum(ps) * (1.0f / 2048.0f) + EPS);
        float w[2]; float mx = 0.f;
#pragma unroll
        for (int hh = 0; hh < 2; ++hh) {
            const int pos = lane + 64 * hh;
            float d = 0.f;
#pragma unroll
            for (int s = 0; s < 16; ++s) d += pu[((size_t)s * NTOK + tok) * 128 + pos];
            const int e = idx[(size_t)tok * 128 + pos];
            w[hh] = gate[(size_t)tok * 128 + pos] * gelu_tanh(d * rinv * su[e]) * sv[e];
            mx = fmaxf(mx, fabsf(w[hh]));
        }
#pragma unroll
        for (int o = 1; o < 64; o <<= 1) mx = fmaxf(mx, __shfl_xor(mx, o));
        mx = fmaxf(mx, 1e-30f);
        const float iv = 127.0f / mx;
#pragma unroll
        for (int hh = 0; hh < 2; ++hh) wq[(size_t)tok * 128 + lane + 64 * hh] = (unsigned char)((int)rintf(w[hh] * iv) & 0xff);
        if (lane == 0) wsc[tok] = mx * (1.0f / 127.0f);
    }
}
#define PV_LOAD_W(wv, tok) do { wv = *(const u32x4*)(wq + (size_t)(tok) * 128 + pr * 16); } while (0)
#define PV_G4(r0, r1, r2, r3, wd, acc) do { _Pragma("unroll") for (int q_ = 0; q_ < 4; ++q_) { \
        const unsigned l01_ = __builtin_amdgcn_perm(r1[q_], r0[q_], 0x05010400u), l23_ = __builtin_amdgcn_perm(r3[q_], r2[q_], 0x05010400u); \
        const unsigned h01_ = __builtin_amdgcn_perm(r1[q_], r0[q_], 0x07030602u), h23_ = __builtin_amdgcn_perm(r3[q_], r2[q_], 0x07030602u); \
        acc[4 * q_ + 0] = __builtin_amdgcn_sdot4((int)__builtin_amdgcn_perm(l23_, l01_, 0x05040100u), (int)(wd), acc[4 * q_ + 0], false); \
        acc[4 * q_ + 1] = __builtin_amdgcn_sdot4((int)__builtin_amdgcn_perm(l23_, l01_, 0x07060302u), (int)(wd), acc[4 * q_ + 1], false); \
        acc[4 * q_ + 2] = __builtin_amdgcn_sdot4((int)__builtin_amdgcn_perm(h23_, h01_, 0x05040100u), (int)(wd), acc[4 * q_ + 2], false); \
        acc[4 * q_ + 3] = __builtin_amdgcn_sdot4((int)__builtin_amdgcn_perm(h23_, h01_, 0x07060302u), (int)(wd), acc[4 * q_ + 3], false); } } while (0)
#define PV_C8(vb, wv, o8, acc) do { PV_G4(vb[0], vb[1], vb[2], vb[3], wv[(o8) / 4], acc); PV_G4(vb[4], vb[5], vb[6], vb[7], wv[(o8) / 4 + 1], acc); } while (0)
#define PV_FINISH(acc, tok) do { \
        int r8_[8]; _Pragma("unroll") for (int k_ = 0; k_ < 8; ++k_) { const int m_ = b2 ? acc[k_ + 8] : acc[k_], o_ = b2 ? acc[k_] : acc[k_ + 8]; r8_[k_] = m_ + __shfl_xor(o_, 32); } \
        int r4_[4]; _Pragma("unroll") for (int k_ = 0; k_ < 4; ++k_) { const int m_ = b1 ? r8_[k_ + 4] : r8_[k_], o_ = b1 ? r8_[k_] : r8_[k_ + 4]; r4_[k_] = m_ + __shfl_xor(o_, 16); } \
        int r2_[2]; _Pragma("unroll") for (int k_ = 0; k_ < 2; ++k_) { const int m_ = b0 ? r4_[k_ + 2] : r4_[k_], o_ = b0 ? r4_[k_] : r4_[k_ + 2]; r2_[k_] = m_ + __shfl_xor(o_, 8); } \
        const float ws_ = wsc[(tok)]; \
        const size_t ho_ = (size_t)(tok) * 2048 + 128 * s + 16 * c + 2 * pr; \
        const unsigned hx_ = *(const unsigned*)(h2b + ho_); \
        const float o0_ = bflo(hx_) + (float)r2_[0] * ws_, o1_ = bfhi(hx_) + (float)r2_[1] * ws_; \
        *(f32x2*)(h3 + ho_) = (f32x2){o0_, o1_}; \
        const float ss_ = wave_sum(o0_ * o0_ + o1_ * o1_); \
        if (lane == 0) partf[(size_t)(tok) * 16 + s] = ss_; \
        _Pragma("unroll") for (int k_ = 0; k_ < 16; ++k_) acc[k_] = 0; } while (0)
__device__ __forceinline__ void ph_peer_v(const Args& a) {
    int tid_ = threadIdx.x; asm volatile("" : "+v"(tid_));
    const int tid = tid_, lane = tid & 63, wave = tid >> 6, pr = lane >> 3, c = lane & 7;
    const bf16* h2b = (const bf16*)(a.ws + WS_AB); float* h3 = (float*)(a.ws + WS_H);
    const unsigned char* Vq = a.ws + WS_VB;
    const int* idx = (const int*)(a.ws + WS_YS);
    const unsigned char* wq = (const unsigned char*)(a.ws + WS_WP); const float* wsc = (const float*)(a.ws + WS_WSUM);
    float* partf = (float*)(a.ws + WS_PARTF);
    const int x = blockIdx.x & 7, nbx = gridDim.x >> 3, bi = blockIdx.x >> 3;
    const bool b2 = (pr & 4) != 0, b1 = (pr & 2) != 0, b0 = (pr & 1) != 0;
    const int tstride = nbx * NWAVES, tfirst = bi * NWAVES + wave, ntok = NTOK / tstride;
    const unsigned coff = 16u * (unsigned)c;
    for (int pass = 0; pass < 2; ++pass) {
        const int s = x + 8 * pass;
        const unsigned char* slab = Vq + (size_t)s * PE * 128;
        int eA[16], eB[16]; u32x4 ub0[8], ub1[8]; u32x4 wA, wB; int acc[16];
#pragma unroll
        for (int k = 0; k < 16; ++k) acc[k] = 0;
        PP_LOAD_IDX(eA, tfirst);
        PP_G8(ub0, eA, 0); PV_LOAD_W(wA, tfirst);
        PP_LOAD_IDX(eB, tfirst + tstride);
        for (int k = 0; k < ntok; k += 2) {
            const int tokA = tfirst + k * tstride, tokB = tokA + tstride;
            const bool more = k + 2 < ntok;
            PP_G8(ub1, eA, 8);
            if (more) PP_LOAD_IDX(eA, tokA + 2 * tstride);
            PV_C8(ub0, wA, 0, acc);
            PP_G8(ub0, eB, 0); PV_LOAD_W(wB, tokB);
            PV_C8(ub1, wA, 8, acc);
            PV_FINISH(acc, tokA);
            PP_G8(ub1, eB, 8);
            if (more) PP_LOAD_IDX(eB, tokB + 2 * tstride);
            PV_C8(ub0, wB, 0, acc);
            if (more) { PP_G8(ub0, eA, 0); PV_LOAD_W(wA, tokA + 2 * tstride); }
            PV_C8(ub1, wB, 8, acc);
            PV_FINISH(acc, tokB);
        }
    }
}
__device__ __forceinline__ void ph_final(const Args& a) {
    int tid_ = threadIdx.x; asm volatile("" : "+v"(tid_));
    const int tid = tid_, lane = tid & 63, wave = tid >> 6;
    const float* h3 = (const float*)(a.ws + WS_H); const float* partf = (const float*)(a.ws + WS_PARTF); const float* gfin = a.in[30];
    const int step = gridDim.x * NWAVES;
#define FN_LOAD(v, ps, tok) do { ps = (lane < 16) ? partf[(size_t)(tok) * 16 + lane] : 0.f; \
        _Pragma("unroll") for (int j_ = 0; j_ < 8; ++j_) v[j_] = __builtin_nontemporal_load((const f32x4*)(h3 + (size_t)(tok) * 2048 + 4 * (lane + 64 * j_))); } while (0)
#define FN_PROC(v, ps, tok) do { const float rf_ = 1.0f / sqrtf(wave_sum(ps) * (1.0f / 2048.0f) + EPS); \
        _Pragma("unroll") for (int j_ = 0; j_ < 8; ++j_) { const f32x4 g_ = *(const f32x4*)(gfin + 4 * (lane + 64 * j_)); \
            __builtin_nontemporal_store(v[j_] * g_ * rf_, (f32x4*)(a.out + (size_t)(tok) * 2048 + 4 * (lane + 64 * j_))); } } while (0)
    f32x4 va[8], vb[8]; float pa = 0.f, pb = 0.f;
    int tok = blockIdx.x * NWAVES + wave;
    if (tok < NTOK) FN_LOAD(va, pa, tok);
    for (; tok < NTOK; tok += 2 * step) {
        const int tn = tok + step;
        if (tn < NTOK) FN_LOAD(vb, pb, tn);
        FN_PROC(va, pa, tok);
        if (tn < NTOK) {
            if (tn + step < NTOK) FN_LOAD(va, pa, tn + step);
            FN_PROC(vb, pb, tn);
        }
    }
#undef FN_LOAD
#undef FN_PROC
}

#define XB_TMO      128
#define XB_XCNT(j)  (256  + 64 * (j))
#define XB_XSUB(j)  (1280 + 64 * (j))
#define XB_XGEN(j)  (2304 + 64 * (j))
#define XB_TOP      3328
#define XB_TOPGEN   3392
#define XCD_BAR_WORDS 3456
#define XB_SPIN_CAP (1u << 18)
__device__ __forceinline__ unsigned xb_ld(unsigned* p)              { return __hip_atomic_load(p, __ATOMIC_RELAXED, __HIP_MEMORY_SCOPE_AGENT); }
__device__ __forceinline__ unsigned xb_add(unsigned* p, unsigned v) { return __hip_atomic_fetch_add(p, v, __ATOMIC_RELAXED, __HIP_MEMORY_SCOPE_AGENT); }
__device__ __forceinline__ unsigned xb_xcc_id() { return (unsigned)__builtin_amdgcn_s_getreg((3 << 11) | 20) & 0xFu; }
#define XB_SPIN(cond, bar) do { unsigned _sp = 0; while (cond) { __builtin_amdgcn_s_sleep(1); \
    if ((++_sp & 255u) == 0u) { if (xb_ld(&(bar)[XB_TMO])) break; if (_sp > XB_SPIN_CAP) { atomicAdd(&(bar)[XB_TMO], 1u); break; } } } } while (0)
struct XcdBarrier { unsigned* bar; unsigned x; volatile LAS unsigned* st; };
__device__ __forceinline__ XcdBarrier xcd_barrier_post(unsigned* bar, volatile LAS unsigned* st) {
    XcdBarrier b; b.bar = bar; b.x = xb_xcc_id(); b.st = st;
    if (threadIdx.x == 0) (void)xb_add(&bar[XB_XCNT(b.x)], 1u);
    return b;
}
__device__ __forceinline__ void xcd_barrier_complete(unsigned* bar, unsigned x, unsigned& nloc, unsigned& nx) {
    const unsigned G = gridDim.x * gridDim.y * gridDim.z;
    unsigned sum, cnt, mine, sp = 0u;
    for (;;) {
        sum = 0u; cnt = 0u; mine = 0u;
#pragma unroll
        for (unsigned j = 0; j < 16; ++j) { const unsigned c = xb_ld(&bar[XB_XCNT(j)]); sum += c; cnt += (c > 0u) ? 1u : 0u; mine = (j == x) ? c : mine; }
        if (sum == G) break;
        __builtin_amdgcn_s_sleep(1);
        if ((++sp & 255u) == 0u) { if (xb_ld(&bar[XB_TMO])) break; if (sp > XB_SPIN_CAP) { atomicAdd(&bar[XB_TMO], 1u); break; } }
    }
    nloc = mine > 0u ? mine : 1u; nx = cnt > 0u ? cnt : 1u;
}
__device__ __forceinline__ void xcd_barrier(const XcdBarrier& b) {
    asm volatile("s_waitcnt vmcnt(0)" ::: "memory");
    __syncthreads();
    if (threadIdx.x == 0) {
        unsigned* bar = b.bar;
        __builtin_amdgcn_s_waitcnt(0);
        unsigned nloc = b.st[0], nx = b.st[1];
        if (nloc == 0u) { xcd_barrier_complete(bar, b.x, nloc, nx); b.st[0] = nloc; b.st[1] = nx; }
        const unsigned old = xb_add(&bar[XB_XSUB(b.x)], 1u);
        const unsigned gen = old / nloc;
        if (old + 1u == (gen + 1u) * nloc) {
            __builtin_amdgcn_fence(__ATOMIC_RELEASE, "agent");
            asm volatile("s_waitcnt vmcnt(0)" ::: "memory");
            const unsigned og = xb_add(&bar[XB_TOP], 1u);
            const unsigned tg = og / nx;
            if (og + 1u == (tg + 1u) * nx) xb_add(&bar[XB_TOPGEN], 1u);
            else XB_SPIN(xb_ld(&bar[XB_TOPGEN]) == tg, bar);
            __builtin_amdgcn_fence(__ATOMIC_ACQUIRE, "agent");
            xb_add(&bar[XB_XGEN(b.x)], 1u);
            asm volatile("s_waitcnt vmcnt(0)" ::: "memory");
        } else {
            XB_SPIN(xb_ld(&bar[XB_XGEN(b.x)]) == gen, bar);
            __builtin_amdgcn_fence(__ATOMIC_ACQUIRE, "agent");
            asm volatile("s_waitcnt vmcnt(0)" ::: "memory");
        }
    }
    __syncthreads();
}

constexpr int MISC_OFF = LDS_BYTES - 128;
constexpr size_t CTL_ZERO_BYTES = 65536;
__global__ void __launch_bounds__(NTHREADS, 2) mk_fwd(Args a) {
    extern __shared__ __attribute__((aligned(16))) unsigned char lds_raw[];
    LAS unsigned char* lds = (LAS unsigned char*)lds_raw;
    unsigned char* ws = a.ws;
    for (int u = threadIdx.x; u < 32; u += NTHREADS) ((LAS unsigned*)(lds + MISC_OFF))[u] = 0u;
    __syncthreads();
    (void)xcd_barrier_post((unsigned*)(ws + WS_CTL), (volatile LAS unsigned*)(lds + MISC_OFF) + 8);
#define GRID_BAR() do { XcdBarrier bar_; bar_.bar = (unsigned*)(a.ws + WS_CTL); bar_.x = xb_xcc_id(); bar_.st = (volatile LAS unsigned*)(lds + MISC_OFF) + 8; xcd_barrier(bar_); } while (0)
    ph_prologue(a, lds);
    GRID_BAR();
    {
        { Epi<0> E{nullptr, nullptr, (bf16*)(ws + WS_PROJ), NIN, 1.0f, nullptr, 0, nullptr, nullptr, nullptr, nullptr, 0};
          run_gemm(lds, (const bf16*)(ws + WS_AB), (const bf16*)(ws + WS_WIN), NTOK, NIN, 2048, E); }
        { Epi<0> E{nullptr, nullptr, (bf16*)(ws + WS_KV), 4096, 1.0f, nullptr, 0, nullptr, nullptr, nullptr, nullptr, 0};
          run_gemm(lds, (const bf16*)(ws + WS_MEMN), (const bf16*)(ws + WS_WKV), NMEMTOK, 4096, 2048, E, 128); }
        if (blockIdx.x >= 160) quant_rows(a, ((int)blockIdx.x - 160) * 64, ((int)blockIdx.x - 160) * 64 + 64);
    }
    GRID_BAR();
    ph_conv(a, lds);
    ph_s5(a, lds);
    GRID_BAR();
    {
        { Epi<1> E{nullptr, nullptr, (bf16*)(ws + WS_Y), 2048, 1.0f, nullptr, 0, (const bf16*)(ws + WS_Z), nullptr, nullptr, (float*)(ws + WS_PARTS), 16};
          run_gemm(lds, (const bf16*)(ws + WS_Z), (const bf16*)(ws + WS_WGLU), NTOK, 1024, 1024, E); }
        const bf16* kv = (const bf16*)(ws + WS_KV);
        for (int bh = 0; bh < 8; ++bh) {
            const int b = bh >> 2, h = bh & 3;
            Epi<0> E{nullptr, nullptr, (bf16*)(ws + WS_G) + ((size_t)b * 1024 + h * 256) * 2048, 2048, 1.0f, nullptr, 0, nullptr, nullptr, nullptr, nullptr, 0};
            run_gemm(lds, kv + (size_t)b * 256 * 4096 + h * 512, (const bf16*)(ws + WS_WQ) + h * 512, 256, 2048, 512, E, 128 + 8 * bh, 4096, 2048);
        }
        for (int bh = 0; bh < 8; ++bh) {
            const int b = bh >> 2, h = bh & 3;
            Epi<0> E{nullptr, nullptr, (bf16*)(ws + WS_HC) + (size_t)b * 2048 * 1024 + h * 256, 1024, 1.0f, nullptr, 0, nullptr, nullptr, nullptr, nullptr, 0};
            run_gemm(lds, (const bf16*)(ws + WS_WO) + h * 512, kv + (size_t)b * 256 * 4096 + 2048 + h * 512, 2048, 256, 512, E, 192 + 8 * bh, 2048, 4096);
        }
    }
    GRID_BAR();
    {
        {
            const int c0 = (int)blockIdx.x, wg0 = (c0 & 7) * 32 + (c0 >> 3), pm0 = (wg0 >> 6) * 8 + ((wg0 & 63) & 7);
            const float* mp = (const float*)(ws + WS_PARTS);
            if (threadIdx.x < 256) {
                const int row = pm0 * 256 + (int)threadIdx.x; float s = 0.f;
#pragma unroll
                for (int i = 0; i < 16; i += 4) { const f32x4 v = *(const f32x4*)(mp + (size_t)row * 16 + i); s += (v[0] + v[1]) + (v[2] + v[3]); }
                ((LAS float*)(lds + 131072))[threadIdx.x] = 1.0f / sqrtf(s * (1.0f / 1024.0f) + EPS);
            }
            __syncthreads();
        }
        Epi<2, true> E{(const float*)(ws + WS_PARTS), lds + 131072, (bf16*)(ws + WS_AB), 2048, 1.0f, nullptr, 0, nullptr, a.in[0], nullptr, (float*)(ws + WS_PART1), 32};
        run_gemm(lds, (const bf16*)(ws + WS_Y), (const bf16*)(ws + WS_WOUT), NTOK, 2048, 2048, E);
    }
    GRID_BAR();
    {
        for (int b = 0; b < 2; ++b) {
            EpiSoftmax E{(bf16*)(ws + WS_P) + (size_t)b * SEQ * 1024, 1024, (const float*)(ws + WS_PART1) + (size_t)b * SEQ * 32, 0.044194173824159216f};
            run_gemm<EpiSoftmax, false>(lds, (const bf16*)(ws + WS_AB) + (size_t)b * SEQ * 2048, (const bf16*)(ws + WS_G) + (size_t)b * 1024 * 2048, SEQ, 1024, 2048, E, 64 * b);
        }
        if (blockIdx.x >= 128) quant_rows(a, 6144 + ((int)blockIdx.x - 128) * 104, 6144 + ((int)blockIdx.x - 128) * 104 + 104);
    }
    GRID_BAR();
    {
        for (int b = 0; b < 2; ++b) {
            Epi<2> E{nullptr, nullptr, (bf16*)(ws + WS_AB) + (size_t)b * SEQ * 2048, 2048, 1.0f, nullptr, 0, (const bf16*)(ws + WS_AB) + (size_t)b * SEQ * 2048, nullptr, nullptr, (float*)(ws + WS_PART2) + (size_t)b * SEQ * 32, 32};
            run_gemm(lds, (const bf16*)(ws + WS_P) + (size_t)b * SEQ * 1024, (const bf16*)(ws + WS_HC) + (size_t)b * 2048 * 1024, SEQ, 2048, 1024, E, 128 * b);
        }
    }
    GRID_BAR();
    {
        Epi<0> E{nullptr, nullptr, (bf16*)(ws + WS_Z), 1024, 1.0f, (const float*)(ws + WS_PART2), 32, nullptr, nullptr, nullptr, nullptr, 0};
        run_gemm(lds, (const bf16*)(ws + WS_AB), (const bf16*)(ws + WS_WPQ), NTOK, 1024, 2048, E);
        if (blockIdx.x >= 128) quant_rows(a, 19456 + ((int)blockIdx.x - 128) * 104, 19456 + ((int)blockIdx.x - 128) * 104 + 104);
    }
    GRID_BAR();
    ph_topk(a, lds);
    GRID_BAR();
    ph_peer_u(a);
    GRID_BAR();
    ph_peer_w(a);
    GRID_BAR();
    ph_peer_v(a);
    GRID_BAR();
    ph_final(a);
}

extern "C" void kernel_launch(void* const* d_in, const int* in_sizes, int n_in, void* d_out, int out_size, void* d_ws, size_t ws_size, hipStream_t stream) {
    if (n_in != 31 || ws_size < WS_END) { fprintf(stderr, "kernel_launch: unexpected inputs (n_in %d, ws %zu)\n", n_in, ws_size); return; }
    static int grid = 0;
    if (grid == 0) {
        int dev = 0, cus = 0, per_cu = 0;
        if (hipGetDevice(&dev) != hipSuccess || hipDeviceGetAttribute(&cus, hipDeviceAttributeMultiprocessorCount, dev) != hipSuccess) { grid = -1; return; }
        if (hipFuncSetAttribute((const void*)mk_fwd, hipFuncAttributeMaxDynamicSharedMemorySize, LDS_BYTES) != hipSuccess) { grid = -1; return; }
        if (hipOccupancyMaxActiveBlocksPerMultiprocessor(&per_cu, (const void*)mk_fwd, NTHREADS, LDS_BYTES) != hipSuccess || per_cu < 1) { fprintf(stderr, "kernel_launch: occupancy query says %d\n", per_cu); }
        (void)hipGetLastError();
        grid = 256;
        if (cus != 256) fprintf(stderr, "kernel_launch: built for 256 CUs, device reports %d\n", cus);
    }
    if (grid < 0) return;
    (void)hipMemsetAsync((char*)d_ws + WS_CTL, 0, CTL_ZERO_BYTES, stream);
    Args a{};
    for (int i = 0; i < 31; ++i) a.in[i] = (const float*)d_in[i];
    a.out = (float*)d_out; a.ws = (unsigned char*)d_ws;
    hipLaunchKernelGGL(mk_fwd, dim3(grid), dim3(NTHREADS), LDS_BYTES, stream, a);
}
```

```cpp
#include <hip/hip_runtime.h>
#include <cstdio>
#include <cstdint>
namespace pg8 {
#define PG8_LAS __attribute__((address_space(3)))
typedef unsigned short bf16_t;
typedef short bf16x8 __attribute__((ext_vector_type(8)));
typedef float f32x4 __attribute__((ext_vector_type(4)));
typedef unsigned u32x4 __attribute__((ext_vector_type(4)));
constexpr int BM = 256, BK = 64, HALF = 128, HTB = HALF * BK * 2  , STAGE_BYTES = 8 * HTB, NXCD = 8, WGM = 8;

__host__ __device__ __forceinline__ int lds_byte(int r, int c) { const int st = (r >> 4) * 2 + (c >> 5), rr = r & 15, cc = c & 31, ob = rr * 64 + cc * 2; return st * 1024 + (ob ^ (((ob >> 9) & 1) << 5)); }
__host__ __device__ __forceinline__ void stage_rc(int b, int& R, int& C) { const int st = b / 1024, sb = b % 1024, swz = sb ^ (((sb >> 9) & 1) << 5); R = (st >> 1) * 16 + swz / 64; C = (st & 1) * 32 + (swz % 64) / 2; }
__host__ __device__ __forceinline__ int perm32(int rho) { const int n = rho >> 4, i = rho & 15; return 8 * (i >> 2) + 4 * n + (i & 3); }

struct Unit { int pm, pn; };
struct Gemm { const bf16_t* A; const bf16_t* Bt; int M, N, K, lda, ldb; };

struct StaticOrder {
    int nM, nN, nwg, G, c;
    __host__ __device__ void init(int M, int N, int G_, int c_) { nM = M / BM; nN = N / BM; nwg = nM * nN; G = G_; c = c_; }
    __host__ __device__ bool next(int i, Unit& u) const {
        const long L = (long)i * G + c; if (L >= nwg) return false;
        int wgid = (int)L; { const int q = nwg / NXCD, r = nwg % NXCD, xcd = wgid % NXCD, off = wgid / NXCD; wgid = (xcd < r ? xcd * (q + 1) : r * (q + 1) + (xcd - r) * q) + off; }
        const int nig = WGM * nN, gid = wgid / nig, fm = gid * WGM, gsz = (nM - fm) < WGM ? (nM - fm) : WGM;
        u.pm = fm + ((wgid % nig) % gsz); u.pn = (wgid % nig) / gsz; return true;
    }
    __device__ __forceinline__ void a_ready(const Unit&) const {}
    __device__ __forceinline__ void done(const Unit&) const {}
};

__device__ __forceinline__ unsigned cvt_pk_bf16(float lo, float hi) { unsigned r; asm volatile("v_cvt_pk_bf16_f32 %0, %1, %2" : "=v"(r) : "v"(lo), "v"(hi)); return r; }

template <class Epi, class Sched, bool ALIGN_EPI = false, bool SP2 = false>
__device__ __forceinline__ void gemm_phase(PG8_LAS unsigned char* lds, const Gemm g, const Sched& S, const Epi& E) {
    int tid_ = threadIdx.x; asm volatile("" : "+v"(tid_));
    const int tid = tid_, wid = __builtin_amdgcn_readfirstlane(tid >> 6), lane = tid & 63, wr = wid >> 2, wc = wid & 3, fr = lane & 15, fq = lane >> 4;
    const int K = g.K, nt = K / BK;
    unsigned voffA[2], voffB[2];
#pragma unroll
    for (int i = 0; i < 2; ++i) { int R, C; stage_rc(tid * 16 + i * 8192, R, C); const int Rb = Epi::PERM ? ((R & ~31) + perm32(R & 31)) : R;
        voffA[i] = (unsigned)(R * g.lda + C) * 2u; voffB[i] = (unsigned)(Rb * g.ldb + C) * 2u; }
    const size_t kstep = (size_t)(BK * 2);
    const size_t hstepA = (size_t)HALF * g.lda * 2, hstepB = (size_t)HALF * g.ldb * 2;
    const size_t tstepA = 2 * hstepA, tstepB = 2 * hstepB;
    const unsigned ldsw = (unsigned)wid * 1024u;
    const int aoff = lds_byte(wr * 64 + fr, fq * 8), boff = lds_byte(wc * 32 + fr, fq * 8);
#define PG8_SA(b, h) (((b) * 2 + (h)) * HTB)
#define PG8_SB(b, h) ((4 + (b) * 2 + (h)) * HTB)
#define PG8_STAGE(bufoff, gbase, voff) do { _Pragma("unroll") for (int _i = 0; _i < 2; ++_i) \
        __builtin_amdgcn_global_load_lds((const unsigned*)((const char*)(gbase) + (voff)[_i]), (PG8_LAS unsigned*)(lds + (bufoff) + ldsw + _i * 8192), 16, 0, 0); } while (0)
#define PG8_LDA(dst, b, h) do { _Pragma("unroll") for (int m = 0; m < 4; ++m) _Pragma("unroll") for (int k = 0; k < 2; ++k) dst[m][k] = *(const PG8_LAS bf16x8*)(lds + PG8_SA(b, h) + aoff + m * 2048 + k * 1024); } while (0)
#define PG8_LDB(dst, b, h) do { _Pragma("unroll") for (int n = 0; n < 2; ++n) _Pragma("unroll") for (int k = 0; k < 2; ++k) dst[n][k] = *(const PG8_LAS bf16x8*)(lds + PG8_SB(b, h) + boff + n * 2048 + k * 1024); } while (0)
#define PG8_MMA(ai, bj, At, Bt) do { __builtin_amdgcn_s_setprio(1); _Pragma("unroll") for (int m = 0; m < 4; ++m) _Pragma("unroll") for (int n = 0; n < 2; ++n) _Pragma("unroll") for (int k = 0; k < 2; ++k) \
        acc[ai][bj][m][n] = __builtin_amdgcn_mfma_f32_16x16x32_bf16(Bt[n][k], At[m][k], acc[ai][bj][m][n], 0, 0, 0); __builtin_amdgcn_s_setprio(0); } while (0)
#define PG8_WAIT_V(n) asm volatile("s_waitcnt vmcnt(" #n ")" ::: "memory")
#define PG8_WAIT_L(n) asm volatile("s_waitcnt lgkmcnt(" #n ")" ::: "memory")
#define PG8_BAR __builtin_amdgcn_s_barrier()
#define PG8_SCHED __builtin_amdgcn_sched_barrier(0)
    Unit cur, nxt; int ui = 0;
    if (!S.next(0, cur)) return;
    f32x4 acc[2][2][4][2];
#pragma unroll
    for (int a = 0; a < 2; ++a)
#pragma unroll
        for (int b = 0; b < 2; ++b)
#pragma unroll
            for (int m = 0; m < 4; ++m)
#pragma unroll
                for (int n = 0; n < 2; ++n) acc[a][b][m][n] = (f32x4){0.f, 0.f, 0.f, 0.f};
    bf16x8 At[4][2], B0[2][2], B1[2][2];
    const char* cA = (const char*)g.A + (size_t)cur.pm * tstepA; const char* cB = (const char*)g.Bt + (size_t)cur.pn * tstepB;
    S.a_ready(cur);
    if constexpr (SP2) {
        PG8_STAGE(PG8_SB(0, 0), cB, voffB); PG8_STAGE(PG8_SB(0, 1), cB + hstepB, voffB); PG8_STAGE(PG8_SA(0, 0), cA, voffA); PG8_STAGE(PG8_SA(0, 1), cA + hstepA, voffA);
        if (wr == 1) PG8_BAR;
        PG8_WAIT_V(2); PG8_BAR;
        PG8_STAGE(PG8_SB(1, 0), cB + kstep, voffB); PG8_STAGE(PG8_SA(1, 0), cA + kstep, voffA); PG8_STAGE(PG8_SB(1, 1), cB + hstepB + kstep, voffB);
        PG8_WAIT_V(6); PG8_BAR;
    } else {
        PG8_STAGE(PG8_SB(0, 0), cB, voffB); PG8_STAGE(PG8_SA(0, 0), cA, voffA); PG8_STAGE(PG8_SB(0, 1), cB + hstepB, voffB); PG8_STAGE(PG8_SA(0, 1), cA + hstepA, voffA);
        if (wr == 1) PG8_BAR;
        PG8_WAIT_V(4); PG8_BAR;
        PG8_STAGE(PG8_SB(1, 0), cB + kstep, voffB); PG8_STAGE(PG8_SA(1, 0), cA + kstep, voffA); PG8_STAGE(PG8_SB(1, 1), cB + hstepB + kstep, voffB);
        PG8_WAIT_V(6); PG8_BAR;
    }
    for (;;) {
        const bool has_next = S.next(ui + 1, nxt);
        const char* nA = has_next ? (const char*)g.A + (size_t)nxt.pm * tstepA : cA; const char* nB = has_next ? (const char*)g.Bt + (size_t)nxt.pn * tstepB : cB;
        for (int t = 0; t < nt; t += 2) {
            if constexpr (Epi::MIDK) { if (t == (nt >> 1)) E.midk(acc, cur, wr, wc, fr, fq); }
            const bool last = (t == nt - 2);
            const char* a1 = cA + (size_t)(t + 1) * kstep;
            const char* a2 = last ? nA : cA + (size_t)(t + 2) * kstep; const char* b2 = last ? nB : cB + (size_t)(t + 2) * kstep;
            const char* a3 = a2 + kstep; const char* b3 = b2 + kstep;
            if (last && has_next) S.a_ready(nxt);
            if constexpr (SP2) {
            PG8_LDB(B0, 0, 0); PG8_LDB(B1, 0, 1); PG8_SCHED; PG8_LDA(At, 0, 0); PG8_STAGE(PG8_SA(1, 1), a1 + hstepA, voffA);
            PG8_WAIT_V(8); PG8_WAIT_L(0); PG8_BAR; PG8_MMA(0, 0, At, B0); PG8_MMA(0, 1, At, B1); PG8_BAR; PG8_SCHED;
            PG8_LDA(At, 0, 1); PG8_STAGE(PG8_SB(0, 0), b2, voffB); PG8_STAGE(PG8_SB(0, 1), b2 + hstepB, voffB); PG8_STAGE(PG8_SA(0, 0), a2, voffA);
            PG8_WAIT_V(8); PG8_WAIT_L(0); PG8_BAR; PG8_MMA(1, 0, At, B0); PG8_MMA(1, 1, At, B1); PG8_BAR; PG8_SCHED;
            PG8_LDB(B0, 1, 0); PG8_LDB(B1, 1, 1); PG8_SCHED; PG8_LDA(At, 1, 0); PG8_STAGE(PG8_SA(0, 1), a2 + hstepA, voffA);
            PG8_WAIT_V(8); PG8_WAIT_L(0); PG8_BAR; PG8_MMA(0, 0, At, B0); PG8_MMA(0, 1, At, B1); PG8_BAR; PG8_SCHED;
            PG8_LDA(At, 1, 1); PG8_STAGE(PG8_SB(1, 0), b3, voffB); PG8_STAGE(PG8_SB(1, 1), b3 + hstepB, voffB); PG8_STAGE(PG8_SA(1, 0), a3, voffA);
            PG8_WAIT_V(8); PG8_WAIT_L(0); PG8_BAR; PG8_MMA(1, 0, At, B0); PG8_MMA(1, 1, At, B1); PG8_BAR; PG8_SCHED;
            } else {
            PG8_LDB(B0, 0, 0); PG8_SCHED; PG8_LDA(At, 0, 0); PG8_STAGE(PG8_SA(1, 1), a1 + hstepA, voffA);
            PG8_WAIT_L(8); PG8_BAR; PG8_WAIT_L(0); PG8_MMA(0, 0, At, B0); PG8_BAR; PG8_SCHED;
            PG8_LDB(B1, 0, 1); PG8_STAGE(PG8_SB(0, 0), b2, voffB);
            PG8_BAR; PG8_WAIT_L(0); PG8_MMA(0, 1, At, B1); PG8_BAR;
            PG8_LDA(At, 0, 1); PG8_STAGE(PG8_SA(0, 0), a2, voffA);
            PG8_BAR; PG8_WAIT_L(0); PG8_MMA(1, 0, At, B0); PG8_BAR; PG8_SCHED;
            PG8_STAGE(PG8_SB(0, 1), b2 + hstepB, voffB);
            PG8_WAIT_V(6); PG8_BAR; PG8_MMA(1, 1, At, B1); PG8_BAR;
            PG8_LDB(B0, 1, 0); PG8_SCHED; PG8_LDA(At, 1, 0); PG8_STAGE(PG8_SA(0, 1), a2 + hstepA, voffA);
            PG8_WAIT_L(8); PG8_BAR; PG8_WAIT_L(0); PG8_MMA(0, 0, At, B0); PG8_BAR; PG8_SCHED;
            PG8_LDB(B1, 1, 1); PG8_STAGE(PG8_SB(1, 0), b3, voffB);
            PG8_BAR; PG8_WAIT_L(0); PG8_MMA(0, 1, At, B1); PG8_BAR;
            PG8_LDA(At, 1, 1); PG8_STAGE(PG8_SA(1, 0), a3, voffA);
            PG8_BAR; PG8_WAIT_L(0); PG8_MMA(1, 0, At, B0); PG8_BAR; PG8_SCHED;
            PG8_STAGE(PG8_SB(1, 1), b3 + hstepB, voffB);
            PG8_WAIT_V(6); PG8_BAR; PG8_MMA(1, 1, At, B1); PG8_BAR;
            }
        }
        if constexpr (ALIGN_EPI) { if (wr == 0) PG8_BAR; }
        if constexpr (!Epi::AFTER_DRAIN) { E(acc, cur, wr, wc, fr, fq); S.done(cur); }
        if (!has_next) break;
#pragma unroll
        for (int a = 0; a < 2; ++a)
#pragma unroll
            for (int b = 0; b < 2; ++b)
#pragma unroll
                for (int m = 0; m < 4; ++m)
#pragma unroll
                    for (int n = 0; n < 2; ++n) acc[a][b][m][n] = (f32x4){0.f, 0.f, 0.f, 0.f};
        cur = nxt; cA = nA; cB = nB; ++ui;
        if constexpr (ALIGN_EPI) { if (wr == 1) PG8_BAR; }
    }
    PG8_WAIT_V(0);
    if constexpr (!ALIGN_EPI) { if (wr == 0) PG8_BAR; }
    PG8_BAR;
    if constexpr (Epi::AFTER_DRAIN) { E.fused(acc, cur, wr, wc, fr, fq, lds, wid, lane); S.done(cur); }
#undef PG8_SA
#undef PG8_SB
#undef PG8_STAGE
#undef PG8_LDA
#undef PG8_LDB
#undef PG8_MMA
#undef PG8_WAIT_V
#undef PG8_WAIT_L
#undef PG8_BAR
#undef PG8_SCHED
}
}

constexpr int NTOK = 8192, SEQ = 4096, DM = 2048, DC = 1024, DS = 1024, NIN = 3072;
constexpr int NMEMTOK = 512  , HD = 512;
constexpr int PE = 16384;
constexpr float EPS = 1e-6f;
constexpr int NTHREADS = 512, NWAVES = 8;
constexpr int LDS_BYTES = 147456;

#define LAS __attribute__((address_space(3)))
typedef unsigned short bf16;
typedef float f32x4 __attribute__((ext_vector_type(4)));
typedef float f32x2 __attribute__((ext_vector_type(2)));
typedef short bf16x8 __attribute__((ext_vector_type(8)));
typedef unsigned u32x4 __attribute__((ext_vector_type(4)));
typedef unsigned u32x2 __attribute__((ext_vector_type(2)));

constexpr size_t MiB = 1u << 20;
constexpr size_t WS_CTL = 0;
constexpr size_t WS_WIN = 1 * MiB, WS_WKV = 13 * MiB, WS_WGLU = 29 * MiB, WS_WOUT = 31 * MiB, WS_WQ = 39 * MiB, WS_WO = 47 * MiB, WS_WPQ = 55 * MiB;
constexpr size_t WS_KEYS = 59 * MiB;
constexpr size_t WS_PART1 = 60 * MiB, WS_PART2 = 61 * MiB, WS_PARTS = 62 * MiB;
constexpr size_t WS_UB = 64 * MiB, WS_VB = 96 * MiB;
constexpr size_t WS_QSC = 63 * MiB;
constexpr size_t WS_AB = 192 * MiB;
constexpr size_t WS_PROJ = 224 * MiB;
constexpr size_t WS_MEMN = 272 * MiB, WS_KV = 274 * MiB;
constexpr size_t WS_G = 224 * MiB;
constexpr size_t WS_HC = 232 * MiB;
constexpr size_t WS_P = 240 * MiB;
constexpr size_t WS_Z = 278 * MiB;
constexpr size_t WS_YS = 294 * MiB;
constexpr size_t WS_Y = 310 * MiB;
constexpr size_t WS_H = 342 * MiB;
constexpr size_t WS_S5E = 406 * MiB, WS_S5F = 410 * MiB, WS_S5K = 414 * MiB, WS_S5L = 415 * MiB;
constexpr size_t WS_PU = 128 * MiB;
constexpr size_t WS_WP = 416 * MiB;
constexpr size_t WS_WSUM = 420 * MiB;
constexpr size_t WS_PARTF = 421 * MiB;
constexpr size_t WS_END = 422 * MiB;
constexpr int CW_CONVQ = 4096;

struct Args {
    const float* in[31];
    float* out;
    unsigned char* ws;
};

__device__ __forceinline__ unsigned f2bf(float f) { unsigned u = __builtin_bit_cast(unsigned, f); return (u + 0x7fffu + ((u >> 16) & 1u)) >> 16; }
__device__ __forceinline__ unsigned pk2(float lo, float hi) { return f2bf(lo) | (f2bf(hi) << 16); }
__device__ __forceinline__ float bflo(unsigned w) { return __builtin_bit_cast(float, w << 16); }
__device__ __forceinline__ float bfhi(unsigned w) { return __builtin_bit_cast(float, w & 0xffff0000u); }
__device__ __forceinline__ float bf2f(bf16 b) { return __builtin_bit_cast(float, (unsigned)b << 16); }
__device__ __forceinline__ float sigmoidf_(float x) { return 1.0f / (1.0f + __expf(-x)); }
__device__ __forceinline__ float gelu_tanh(float x) { const float u = 1.5957691216057308f * (x + 0.044715f * x * x * x); return x / (1.0f + __expf(-u)); }
__device__ __forceinline__ float wave_sum(float v) {
#pragma unroll
    for (int o = 1; o < 64; o <<= 1) v += __shfl_xor(v, o);
    return v;
}
__device__ __forceinline__ unsigned wave_umax(unsigned v) {
#pragma unroll
    for (int o = 1; o < 64; o <<= 1) { const unsigned t = (unsigned)__shfl_xor((int)v, o); v = t > v ? t : v; }
    return v;
}

template <int MODE, bool MIDK_ = false> struct Epi {
    static constexpr bool PERM = true, AFTER_DRAIN = false, MIDK = MIDK_;
    const float* mpart;
    LAS unsigned char* mlds;
    bf16* ob; int ldo; float cs;
    const float* rpart; int rnp;
    const bf16* zin;
    const float* hin; float* hout;
    float* wpart; int wnp;
    __device__ __forceinline__ void midk(pg8::f32x4 (&acc)[2][2][4][2], const pg8::Unit& u, int wr, int wc, int fr, int fq) const {
        const LAS float* rt = (const LAS float*)mlds;
#pragma unroll
        for (int ai = 0; ai < 2; ++ai)
#pragma unroll
            for (int m = 0; m < 4; ++m) {
                const float r = rt[ai * 128 + wr * 64 + m * 16 + fr];
#pragma unroll
                for (int bj = 0; bj < 2; ++bj) { acc[ai][bj][m][0] = acc[ai][bj][m][0] * r; acc[ai][bj][m][1] = acc[ai][bj][m][1] * r; }
            }
    }
    __device__ __forceinline__ void operator()(const pg8::f32x4 (&acc)[2][2][4][2], const pg8::Unit& u, int wr, int wc, int fr, int fq) const {
#pragma unroll
        for (int ai = 0; ai < 2; ++ai)
#pragma unroll
            for (int m = 0; m < 4; ++m) {
                const int row = u.pm * 256 + ai * 128 + wr * 64 + m * 16 + fr;
                float sc = cs;
                if (MODE == 0 && rpart) {
                    float s = 0.f;
                    for (int i = 0; i < rnp; i += 4) { const f32x4 v = *(const f32x4*)(rpart + (size_t)row * rnp + i); s += (v[0] + v[1]) + (v[2] + v[3]); }
                    sc *= 1.0f / sqrtf(s * (1.0f / 2048.0f) + EPS);
                }
                float ss = 0.f;
#pragma unroll
                for (int bj = 0; bj < 2; ++bj) {
                    const int col0 = u.pn * 256 + bj * 128 + wc * 32 + 8 * fq;
                    f32x4 v0 = acc[ai][bj][m][0], v1 = acc[ai][bj][m][1];
                    if (MODE == 0) { v0 = v0 * sc; v1 = v1 * sc; }
                    if (MODE == 1) {
                        const u32x4 zw = *(const u32x4*)(zin + (size_t)row * 1024 + col0);
                        v0[0] = bflo(zw[0]) * sigmoidf_(v0[0]); v0[1] = bfhi(zw[0]) * sigmoidf_(v0[1]); v0[2] = bflo(zw[1]) * sigmoidf_(v0[2]); v0[3] = bfhi(zw[1]) * sigmoidf_(v0[3]);
                        v1[0] = bflo(zw[2]) * sigmoidf_(v1[0]); v1[1] = bfhi(zw[2]) * sigmoidf_(v1[1]); v1[2] = bflo(zw[3]) * sigmoidf_(v1[2]); v1[3] = bfhi(zw[3]) * sigmoidf_(v1[3]);
                    }
                    if (MODE == 2) {
                        if (hin) {
                            const f32x4 h0 = *(const f32x4*)(hin + (size_t)row * 2048 + col0), h1 = *(const f32x4*)(hin + (size_t)row * 2048 + col0 + 4);
                            v0 = v0 + h0; v1 = v1 + h1;
                        } else {
                            const u32x4 hw = *(const u32x4*)(zin + (size_t)row * 2048 + col0);
                            v0[0] += bflo(hw[0]); v0[1] += bfhi(hw[0]); v0[2] += bflo(hw[1]); v0[3] += bfhi(hw[1]);
                            v1[0] += bflo(hw[2]); v1[1] += bfhi(hw[2]); v1[2] += bflo(hw[3]); v1[3] += bfhi(hw[3]);
                        }
                    }
                    if (MODE != 0) ss += (v0[0] * v0[0] + v0[1] * v0[1]) + (v0[2] * v0[2] + v0[3] * v0[3]) + (v1[0] * v1[0] + v1[1] * v1[1]) + (v1[2] * v1[2] + v1[3] * v1[3]);
                    u32x4 w; w[0] = pk2(v0[0], v0[1]); w[1] = pk2(v0[2], v0[3]); w[2] = pk2(v1[0], v1[1]); w[3] = pk2(v1[2], v1[3]);
                    *(u32x4*)(ob + (size_t)row * ldo + col0) = w;
                }
                if (MODE != 0) {
                    ss += __shfl_xor(ss, 16); ss += __shfl_xor(ss, 32);
                    if (fq == 0) wpart[(size_t)row * wnp + u.pn * 4 + wc] = ss;
                }
            }
    }
};

struct EpiSoftmax {
    static constexpr bool PERM = true, AFTER_DRAIN = true, MIDK = false;
    bf16* P; int ldp; const float* rpart; float cs;
    __device__ __forceinline__ void fused(pg8::f32x4 (&acc)[2][2][4][2], const pg8::Unit& u, int wr, int wc, int fr, int fq, LAS unsigned char* lds, int wid, int lane) const {
        LAS float* exm = (LAS float*)lds;
        LAS float* exs = exm + 1024;
        float mloc[2][4];
#pragma unroll
        for (int ai = 0; ai < 2; ++ai)
#pragma unroll
            for (int m = 0; m < 4; ++m) {
                const int rl = ai * 128 + wr * 64 + m * 16 + fr, row = u.pm * 256 + rl;
                float s = 0.f;
#pragma unroll
                for (int i = 0; i < 32; i += 4) { const f32x4 v = *(const f32x4*)(rpart + (size_t)row * 32 + i); s += (v[0] + v[1]) + (v[2] + v[3]); }
                const float sc = cs / sqrtf(s * (1.0f / 2048.0f) + EPS);
                float mx = -3.0e38f;
#pragma unroll
                for (int bj = 0; bj < 2; ++bj)
#pragma unroll
                    for (int n = 0; n < 2; ++n) { acc[ai][bj][m][n] = acc[ai][bj][m][n] * sc; const f32x4 v = acc[ai][bj][m][n]; mx = fmaxf(mx, fmaxf(fmaxf(v[0], v[1]), fmaxf(v[2], v[3]))); }
                mx = fmaxf(mx, __shfl_xor(mx, 16)); mx = fmaxf(mx, __shfl_xor(mx, 32));
                if (fq == 0) exm[rl * 4 + wc] = mx;
            }
        __syncthreads();
#pragma unroll
        for (int ai = 0; ai < 2; ++ai)
#pragma unroll
            for (int m = 0; m < 4; ++m) {
                const int rl = ai * 128 + wr * 64 + m * 16 + fr;
                const f32x4 mv = *(const LAS f32x4*)(exm + rl * 4);
                const float mx = fmaxf(fmaxf(mv[0], mv[1]), fmaxf(mv[2], mv[3]));
                float sm = 0.f;
#pragma unroll
                for (int bj = 0; bj < 2; ++bj)
#pragma unroll
                    for (int n = 0; n < 2; ++n) {
                        f32x4 v = acc[ai][bj][m][n];
                        v[0] = __expf(v[0] - mx); v[1] = __expf(v[1] - mx); v[2] = __expf(v[2] - mx); v[3] = __expf(v[3] - mx);
                        acc[ai][bj][m][n] = v; sm += (v[0] + v[1]) + (v[2] + v[3]);
                    }
                sm += __shfl_xor(sm, 16); sm += __shfl_xor(sm, 32);
                if (fq == 0) exs[rl * 4 + wc] = sm;
                mloc[ai][m] = 0.f;
            }
        __syncthreads();
#pragma unroll
        for (int ai = 0; ai < 2; ++ai)
#pragma unroll
            for (int m = 0; m < 4; ++m) {
                const int rl = ai * 128 + wr * 64 + m * 16 + fr;
                const f32x4 sv = *(const LAS f32x4*)(exs + rl * 4);
                const float inv = 1.0f / ((sv[0] + sv[1]) + (sv[2] + sv[3]));
#pragma unroll
                for (int bj = 0; bj < 2; ++bj) {
                    const f32x4 v0 = acc[ai][bj][m][0] * inv, v1 = acc[ai][bj][m][1] * inv;
                    u32x4 w; w[0] = pk2(v0[0], v0[1]); w[1] = pk2(v0[2], v0[3]); w[2] = pk2(v1[0], v1[1]); w[3] = pk2(v1[2], v1[3]);
                    *(u32x4*)(P + (size_t)(u.pm * 256 + rl) * ldp + u.pn * 256 + bj * 128 + wc * 32 + 8 * fq) = w;
                }
            }
        (void)mloc; (void)wid; (void)lane;
        __syncthreads();
    }
};

template <class EPI, bool ALIGN = true> __device__ __forceinline__ void run_gemm(LAS unsigned char* lds, const bf16* A, const bf16* Bt, int M_, int N_, int K_, const EPI& E, int cshift = 0, int lda = 0, int ldb = 0) {
    pg8::Gemm g{A, Bt, M_, N_, K_, lda ? lda : K_, ldb ? ldb : K_}; pg8::StaticOrder S; S.init(M_, N_, (int)gridDim.x, (int)((blockIdx.x + gridDim.x - cshift) % gridDim.x));
    pg8::gemm_phase<EPI, pg8::StaticOrder, ALIGN, true>(lds, g, S, E);
}

__device__ __forceinline__ void quant_rows(const Args& a, int r0, int r1) {
    int tid_ = threadIdx.x; asm volatile("" : "+v"(tid_));
    const int tid = tid_, lane = tid & 63, wave = tid >> 6;
    unsigned char* ws = a.ws;
    const float* gf = a.in[25];
    unsigned char* Uq = ws + WS_UB; unsigned char* Vq = ws + WS_VB;
    float* su = (float*)(ws + WS_QSC); float* sv = su + PE;
#define QR_LOAD(v, r) do { const float* src_ = (((r) < PE) ? a.in[28] + (size_t)(r) * 2048 : a.in[29] + (size_t)((r) - PE) * 2048); \
        _Pragma("unroll") for (int j_ = 0; j_ < 8; ++j_) v[j_] = __builtin_nontemporal_load((const f32x4*)(src_ + 4 * (lane + 64 * j_))); } while (0)
#define QR_PROC(v, r) do { const bool isu_ = (r) < PE; const int e_ = isu_ ? (r) : (r) - PE; float mx_ = 0.f; \
        _Pragma("unroll") for (int j_ = 0; j_ < 8; ++j_) { if (isu_) v[j_] = v[j_] * *(const f32x4*)(gf + 4 * (lane + 64 * j_)); \
            mx_ = fmaxf(mx_, fmaxf(fmaxf(fabsf(v[j_][0]), fabsf(v[j_][1])), fmaxf(fabsf(v[j_][2]), fabsf(v[j_][3])))); } \
        _Pragma("unroll") for (int o_ = 1; o_ < 64; o_ <<= 1) mx_ = fmaxf(mx_, __shfl_xor(mx_, o_)); \
        mx_ = fmaxf(mx_, 1e-30f); const float inv_ = 127.0f / mx_; unsigned char* tab_ = isu_ ? Uq : Vq; \
        _Pragma("unroll") for (int j_ = 0; j_ < 8; ++j_) { unsigned w_ = 0u; \
            _Pragma("unroll") for (int k_ = 0; k_ < 4; ++k_) { const int q_ = (int)rintf(v[j_][k_] * inv_); w_ |= ((unsigned)q_ & 0xffu) << (8 * k_); } \
            __builtin_nontemporal_store(w_, (unsigned*)(tab_ + ((size_t)(2 * j_ + (lane >> 5)) * PE + e_) * 128 + 4 * (lane & 31))); } \
        if (lane == 0) (isu_ ? su : sv)[e_] = mx_ * (1.0f / 127.0f); } while (0)
    f32x4 va[8], vb[8];
    int r = r0 + wave;
    if (r < r1) QR_LOAD(va, r);
    for (; r < r1; r += 2 * NWAVES) {
        const int rn = r + NWAVES;
        if (rn < r1) QR_LOAD(vb, rn);
        QR_PROC(va, r);
        if (rn < r1) {
            if (rn + NWAVES < r1) QR_LOAD(va, rn + NWAVES);
            QR_PROC(vb, rn);
        }
    }
#undef QR_LOAD
#undef QR_PROC
}

__device__ __forceinline__ void p0_transpose_item(const float* W, int K, int N, bf16* WT, const float* sc0, const float* sc1, int ksplit, LAS float* scr, int item, int lane, int krot = 0) {
    const int nblk = N / 32, kb = item / nblk, nb = item % nblk, k0 = 64 * kb, n0 = 32 * nb;
    f32x4 v[8];
#pragma unroll
    for (int i = 0; i < 8; ++i) {
        const int kk = 8 * i + (lane >> 3), k = (k0 + kk + krot) & (K - 1);
        v[i] = __builtin_nontemporal_load((const f32x4*)(W + (size_t)k * N + n0 + 4 * (lane & 7)));
        if (sc0) v[i] = v[i] * ((k < ksplit) ? sc0[k] : sc1[k - ksplit]);
    }
#pragma unroll
    for (int i = 0; i < 8; ++i) {
        const int kk = 8 * i + (lane >> 3); LAS float* d = scr + kk * 33 + 4 * (lane & 7);
        d[0] = v[i][0]; d[1] = v[i][1]; d[2] = v[i][2]; d[3] = v[i][3];
    }
    asm volatile("s_waitcnt lgkmcnt(0)" ::: "memory");
    const int c = lane & 7;
#pragma unroll
    for (int j = 0; j < 4; ++j) {
        const int n = (lane >> 3) + 8 * j; const LAS float* s = scr + (8 * c) * 33 + n;
        u32x4 o; o[0] = pk2(s[0 * 33], s[1 * 33]); o[1] = pk2(s[2 * 33], s[3 * 33]); o[2] = pk2(s[4 * 33], s[5 * 33]); o[3] = pk2(s[6 * 33], s[7 * 33]);
        *(u32x4*)(WT + (size_t)(n0 + n) * K + k0 + 8 * c) = o;
    }
    asm volatile("s_waitcnt lgkmcnt(0)" ::: "memory");
}
#define RR_LOAD(v, m) do { const float* x_ = ((m) < NTOK) ? a.in[0] + (size_t)(m) * 2048 : a.in[1] + (size_t)((m) - NTOK) * 2048; \
        _Pragma("unroll") for (int j_ = 0; j_ < 8; ++j_) v[j_] = __builtin_nontemporal_load((const f32x4*)(x_ + 4 * (lane + 64 * j_))); } while (0)
#define RR_PROC(v, m) do { const float* gain_ = ((m) < NTOK) ? a.in[2] : a.in[21]; \
        bf16* o_ = ((m) < NTOK) ? (bf16*)(a.ws + WS_AB) + (size_t)(m) * 2048 : (bf16*)(a.ws + WS_MEMN) + (size_t)((m) - NTOK) * 2048; float s_ = 0.f; \
        _Pragma("unroll") for (int j_ = 0; j_ < 8; ++j_) s_ += (v[j_][0] * v[j_][0] + v[j_][1] * v[j_][1]) + (v[j_][2] * v[j_][2] + v[j_][3] * v[j_][3]); \
        const float rinv_ = 1.0f / sqrtf(wave_sum(s_) * (1.0f / 2048.0f) + EPS); \
        _Pragma("unroll") for (int j_ = 0; j_ < 8; ++j_) { const f32x4 g_ = *(const f32x4*)(gain_ + 4 * (lane + 64 * j_)); \
            u32x2 w_; w_[0] = pk2(v[j_][0] * rinv_ * g_[0], v[j_][1] * rinv_ * g_[1]); w_[1] = pk2(v[j_][2] * rinv_ * g_[2], v[j_][3] * rinv_ * g_[3]); \
            *(u32x2*)(o_ + 4 * (lane + 64 * j_)) = w_; } } while (0)
__device__ __forceinline__ void rms_rows_to_bf16(const Args& a, int m0, int step, int m1, int lane) {
    f32x4 va[8], vb[8];
    int m = m0;
    if (m < m1) RR_LOAD(va, m);
    for (; m < m1; m += 2 * step) {
        const int mn = m + step;
        if (mn < m1) RR_LOAD(vb, mn);
        RR_PROC(va, m);
        if (mn < m1) {
            if (mn + step < m1) RR_LOAD(va, mn + step);
            RR_PROC(vb, mn);
        }
    }
}
__device__ __forceinline__ void s5_tables(const Args& a, LAS unsigned char* lds, int g, int part);
__device__ __forceinline__ void ph_prologue(const Args& a, LAS unsigned char* lds) {
    int tid_ = threadIdx.x; asm volatile("" : "+v"(tid_));
    const int tid = tid_, lane = tid & 63, wave = tid >> 6;
    const int gw = blockIdx.x * NWAVES + wave, NGW = gridDim.x * NWAVES;
    LAS float* scr = (LAS float*)(lds + wave * 16384);
    unsigned char* ws = a.ws;
    for (int j = blockIdx.x; j < 256; j += gridDim.x) s5_tables(a, lds, j >> 2, j & 3);
    constexpr int I_IN = 32 * 96, I_KV = 32 * 128, I_GLU = 16 * 32, I_OUT = 32 * 64, I_O = 32 * 64, I_PQ = 32 * 32;
    constexpr int NIT = I_IN + I_KV + I_GLU + I_OUT + I_O + I_PQ;
    for (int it = gw; it < NIT; it += NGW) {
        int r = it;
        if (r < I_IN) { p0_transpose_item(a.in[3], 2048, 3072, (bf16*)(ws + WS_WIN), nullptr, nullptr, 0, scr, r, lane); continue; } r -= I_IN;
        if (r < I_KV) { p0_transpose_item(a.in[23], 2048, 4096, (bf16*)(ws + WS_WKV), nullptr, nullptr, 0, scr, r, lane); continue; } r -= I_KV;
        if (r < I_GLU) { p0_transpose_item(a.in[16], 1024, 1024, (bf16*)(ws + WS_WGLU), nullptr, nullptr, 0, scr, r, lane); continue; } r -= I_GLU;
        if (r < I_OUT) { p0_transpose_item(a.in[19], 2048, 2048, (bf16*)(ws + WS_WOUT), a.in[17], a.in[18], 1024, scr, r, lane, 1024); continue; } r -= I_OUT;
        if (r < I_O) { p0_transpose_item(a.in[24], 2048, 2048, (bf16*)(ws + WS_WO), nullptr, nullptr, 0, scr, r, lane); continue; } r -= I_O;
        p0_transpose_item(a.in[26], 2048, 1024, (bf16*)(ws + WS_WPQ), a.in[25], a.in[25], 2048, scr, r, lane);
    }
    rms_rows_to_bf16(a, gw, NGW, NTOK + NMEMTOK, lane);
    const size_t gt = (size_t)blockIdx.x * NTHREADS + tid, NGT = (size_t)gridDim.x * NTHREADS;
    for (size_t i = gt; i < (size_t)2048 * 2048 / 8; i += NGT) {
        const float gk = a.in[20][(i * 8) >> 11];
        const f32x4 w0 = __builtin_nontemporal_load((const f32x4*)(a.in[22] + i * 8)), w1 = __builtin_nontemporal_load((const f32x4*)(a.in[22] + i * 8 + 4));
        u32x4 o; o[0] = pk2(w0[0] * gk, w0[1] * gk); o[1] = pk2(w0[2] * gk, w0[3] * gk); o[2] = pk2(w1[0] * gk, w1[1] * gk); o[3] = pk2(w1[2] * gk, w1[3] * gk);
        *(u32x4*)((bf16*)(ws + WS_WQ) + i * 8) = o;
    }
    for (size_t i = gt; i < (size_t)(16 * 128 * 64) / 8; i += NGT) {
        const f32x4 k0 = *(const f32x4*)(a.in[27] + i * 8), k1 = *(const f32x4*)(a.in[27] + i * 8 + 4);
        u32x4 o; o[0] = pk2(k0[0], k0[1]); o[1] = pk2(k0[2], k0[3]); o[2] = pk2(k1[0], k1[1]); o[3] = pk2(k1[2], k1[3]);
        *(u32x4*)((bf16*)(ws + WS_KEYS) + i * 8) = o;
    }
}

struct ConvState { f32x2 w[31], acc[31]; unsigned pa[16], pg[16]; f32x2 b; };
__device__ __forceinline__ void conv_norm_row(LAS float* co, const float* lng, const float* lnb, bf16* yr, int wave, int lane) {
    f32x4 v[4]; float s = 0.f;
#pragma unroll
    for (int i = 0; i < 4; ++i) { v[i] = *(LAS f32x4*)(co + wave * 1024 + 4 * (lane + 64 * i)); s += (v[i][0] + v[i][1]) + (v[i][2] + v[i][3]); }
    const float mean = wave_sum(s) * (1.0f / 1024.0f); float q = 0.f;
#pragma unroll
    for (int i = 0; i < 4; ++i) { v[i] = v[i] - mean; q += (v[i][0] * v[i][0] + v[i][1] * v[i][1]) + (v[i][2] * v[i][2] + v[i][3] * v[i][3]); }
    const float rstd = 1.0f / sqrtf(wave_sum(q) * (1.0f / 1024.0f) + EPS); float ss = 0.f;
#pragma unroll
    for (int i = 0; i < 4; ++i) {
        const f32x4 g = *(const f32x4*)(lng + 4 * (lane + 64 * i)), bb = *(const f32x4*)(lnb + 4 * (lane + 64 * i));
#pragma unroll
        for (int e = 0; e < 4; ++e) { const float y = v[i][e] * rstd * g[e] + bb[e]; const float sw = y * sigmoidf_(y); v[i][e] = sw; ss += sw * sw; }
    }
    const float rinv = 1.0f / sqrtf(wave_sum(ss) * (1.0f / 1024.0f) + EPS);
#pragma unroll
    for (int i = 0; i < 4; ++i) { u32x2 o; o[0] = pk2(v[i][0] * rinv, v[i][1] * rinv); o[1] = pk2(v[i][2] * rinv, v[i][3] * rinv); *(u32x2*)(yr + 4 * (lane + 64 * i)) = o; }
}
constexpr int CONV_T = 64, CONV_STEPS = CONV_T + 30, CONV_RING = 16;
template <int TAU> struct ConvStep {
    static __device__ __forceinline__ void run(ConvState& S, const bf16* pbase, int tl0, LAS float* co, const float* lng, const float* lnb, bf16* Y, int t0, int tid, int wave, int lane) {
        __builtin_amdgcn_sched_barrier(0);
        const unsigned av = S.pa[TAU % CONV_RING], gv = S.pg[TAU % CONV_RING];
        if constexpr (TAU + CONV_RING < CONV_STEPS) {
            if constexpr (TAU + CONV_RING < 30) {
                const int tl = tl0 - 30 + TAU + CONV_RING, tlc = tl < 0 ? 0 : tl;
                const unsigned va = *(const unsigned*)(pbase + (size_t)tlc * NIN), vg = *(const unsigned*)(pbase + (size_t)tlc * NIN + 1024);
                S.pa[TAU % CONV_RING] = tl < 0 ? 0u : va; S.pg[TAU % CONV_RING] = vg;
            } else {
                const bf16* pp = pbase + (size_t)(tl0 + (TAU + CONV_RING - 30)) * NIN;
                S.pa[TAU % CONV_RING] = *(const unsigned*)pp; S.pg[TAU % CONV_RING] = *(const unsigned*)(pp + 1024);
            }
        }
        const f32x2 x = (f32x2){bflo(av) * sigmoidf_(bflo(gv)), bfhi(av) * sigmoidf_(bfhi(gv))};
#pragma unroll
        for (int j = 0; j < 31; ++j) S.acc[(TAU + j) % 31] = __builtin_elementwise_fma(S.w[30 - j], x, S.acc[(TAU + j) % 31]);
        constexpr int sl = TAU % 31;
        if constexpr (TAU >= 30) {
            constexpr int row = (TAU - 30) & 7;
            *(LAS f32x2*)(co + row * 1024 + 2 * tid) = S.acc[sl];
            if constexpr (row == 7) {
                __syncthreads();
                conv_norm_row(co, lng, lnb, Y + (size_t)(t0 + (TAU - 37) + wave) * 2048 + 1024, wave, lane);
                __syncthreads();
            }
        }
        S.acc[sl] = S.b;
        ConvStep<TAU + 1>::run(S, pbase, tl0, co, lng, lnb, Y, t0, tid, wave, lane);
    }
};
template <> struct ConvStep<CONV_STEPS> {
    static __device__ __forceinline__ void run(ConvState&, const bf16*, int, LAS float*, const float*, const float*, bf16*, int, int, int, int) {}
};
__device__ __forceinline__ void ph_conv(const Args& a, LAS unsigned char* lds) {
    int tid_ = threadIdx.x; asm volatile("" : "+v"(tid_));
    const int tid = tid_, lane = tid & 63, wave = tid >> 6;
    const bf16* proj = (const bf16*)(a.ws + WS_PROJ);
    bf16* Y = (bf16*)(a.ws + WS_Y);
    LAS float* co = (LAS float*)lds;
    const float* cw = a.in[4]; const float* cb = a.in[5]; const float* lng = a.in[6]; const float* lnb = a.in[7];
    if (blockIdx.x < 128) return;
    ConvState S;
#pragma unroll
    for (int k = 0; k < 31; ++k) S.w[k] = *(const f32x2*)(cw + k * 1024 + 2 * tid);
    S.b = *(const f32x2*)(cb + 2 * tid);
    for (int item = (int)blockIdx.x - 128; item < NTOK / CONV_T; item += 128) {
        const int t0 = item * CONV_T, b = t0 / SEQ, tl0 = t0 % SEQ;
        const bf16* pbase = proj + (size_t)(b * SEQ) * NIN + 2 * tid;
#pragma unroll
        for (int s = 0; s < 31; ++s) S.acc[s] = S.b;
#pragma unroll
        for (int d = 0; d < CONV_RING; ++d) {
            const int tl = tl0 - 30 + d, tlc = tl < 0 ? 0 : tl;
            const unsigned va = *(const unsigned*)(pbase + (size_t)tlc * NIN), vg = *(const unsigned*)(pbase + (size_t)tlc * NIN + 1024);
            S.pa[d] = tl < 0 ? 0u : va; S.pg[d] = vg;
        }
        ConvStep<0>::run(S, pbase, tl0, co, lng, lnb, Y, t0, tid, wave, lane);
    }
}

__device__ __forceinline__ void s5_tables(const Args& a, LAS unsigned char* lds, int g, int part) {
    int tid_ = threadIdx.x; asm volatile("" : "+v"(tid_));
    const int tid = tid_;
    LAS float* pwr = (LAS float*)lds;
    LAS float* pwi = pwr + 17 * 64;
    LAS float* bbr = pwi + 17 * 64;
    LAS float* bbi = bbr + 1024;
    LAS float* cr = bbi + 1024;
    LAS float* ci = cr + 1024;
    const float dt = __expf(a.in[10][g]);
    for (int e = tid; e < 17 * 64; e += NTHREADS) {
        const int n = e >> 6, p = e & 63;
        const float lre = a.in[8][g * 64 + p], lim = a.in[9][g * 64 + p];
        const float er = expf((float)n * lre * dt); float sn, cs; sincosf((float)n * lim * dt, &sn, &cs); pwr[e] = er * cs; pwi[e] = er * sn;
    }
    for (int e = tid; e < 1024; e += NTHREADS) {
        const int p = e >> 4, h = e & 15;
        const float lre = a.in[8][g * 64 + p], lim = a.in[9][g * 64 + p];
        const float er = expf(lre * dt); float sn, cs; sincosf(lim * dt, &sn, &cs);
        const float x = er * cs - 1.0f, y = er * sn, den = 1.0f / (lre * lre + lim * lim);
        const float fr = (x * lre + y * lim) * den, fi = (y * lre - x * lim) * den;
        const float br = a.in[11][((size_t)g * 64 + p) * 16 + h], bi = a.in[12][((size_t)g * 64 + p) * 16 + h];
        bbr[e] = fr * br - fi * bi; bbi[e] = fr * bi + fi * br;
        cr[e] = a.in[13][(size_t)g * 1024 + e]; ci[e] = a.in[14][(size_t)g * 1024 + e];
    }
    __syncthreads();
    bf16* E = (bf16*)(a.ws + WS_S5E) + (size_t)g * 32768;
    bf16* F = (bf16*)(a.ws + WS_S5F) + (size_t)g * 32768;
    bf16* K16 = (bf16*)(a.ws + WS_S5K) + (size_t)g * 4096;
    float* L16 = (float*)(a.ws + WS_S5L) + (size_t)g * 128;
    for (int e2 = part * 4096 + tid; e2 < part * 4096 + 4096; e2 += NTHREADS) {
        const int row = e2 >> 7, col = (e2 & 127) * 2, c2 = row >> 6, p = row & 63, j = col >> 4, h0 = col & 15;
        const float pr = pwr[(15 - j) * 64 + p], pi = pwi[(15 - j) * 64 + p];
        float v[2];
#pragma unroll
        for (int t = 0; t < 2; ++t) { const float br = bbr[p * 16 + h0 + t], bi = bbi[p * 16 + h0 + t]; v[t] = c2 ? (pr * bi + pi * br) : (pr * br - pi * bi); }
        *(unsigned*)(E + (size_t)row * 256 + col) = pk2(v[0], v[1]);
    }
    for (int e2 = part * 4096 + tid; e2 < part * 4096 + 4096; e2 += NTHREADS) {
        const int row = e2 >> 6, col = (e2 & 63) * 2, r = row >> 4, h = row & 15, c2 = col >> 6, p0 = col & 63;
        float v[2];
#pragma unroll
        for (int t = 0; t < 2; ++t) {
            const int p = p0 + t; const float pr = pwr[(r + 1) * 64 + p], pi = pwi[(r + 1) * 64 + p], xr = cr[h * 64 + p], xi = ci[h * 64 + p];
            v[t] = c2 ? -(xr * pi + xi * pr) : (xr * pr - xi * pi);
        }
        *(unsigned*)(F + (size_t)row * 128 + col) = pk2(v[0], v[1]);
    }
    {
        const int e2 = part * 512 + tid;
        const int tau = e2 >> 7, h = (e2 >> 3) & 15, hp0 = (e2 & 7) * 2;
        float s0 = 0.f, s1 = 0.f;
        for (int p = 0; p < 64; ++p) {
            const float pr = pwr[tau * 64 + p], pi = pwi[tau * 64 + p], xr = cr[h * 64 + p], xi = ci[h * 64 + p];
            const float wr = xr * pr - xi * pi, wi = xr * pi + xi * pr;
            s0 += wr * bbr[p * 16 + hp0] - wi * bbi[p * 16 + hp0]; s1 += wr * bbr[p * 16 + hp0 + 1] - wi * bbi[p * 16 + hp0 + 1];
        }
        *(unsigned*)(K16 + (size_t)(tau * 16 + h) * 16 + hp0) = pk2(s0, s1);
    }
    if (part == 0 && tid < 64) { L16[tid] = pwr[16 * 64 + tid]; L16[64 + tid] = pwi[16 * 64 + tid]; }
    __syncthreads();
}

__device__ __forceinline__ void ph_s5(const Args& a, LAS unsigned char* lds) {
    int tid_ = threadIdx.x; asm volatile("" : "+v"(tid_));
    const int tid = tid_, lane = tid & 63, wave = __builtin_amdgcn_readfirstlane(tid >> 6), l15 = lane & 15, s4 = lane >> 4;
    const bf16* proj = (const bf16*)(a.ws + WS_PROJ);
    bf16* Z = (bf16*)(a.ws + WS_Z);
    LAS float* lbuf = (LAS float*)(lds + 2 * 33792);
    LAS unsigned char* sb = lds + 2 * 33792 + 33280;
    for (int prob = blockIdx.x; prob < 128; prob += gridDim.x) {
        const int b = prob >> 6, g = prob & 63;
        const bf16* E = (const bf16*)(a.ws + WS_S5E) + (size_t)g * 32768;
        const bf16* F = (const bf16*)(a.ws + WS_S5F) + (size_t)g * 32768;
        const bf16* K16 = (const bf16*)(a.ws + WS_S5K) + (size_t)g * 4096;
        const float* L16 = (const float*)(a.ws + WS_S5L) + (size_t)g * 128;
        const float l16r = L16[lane], l16i = L16[64 + lane];
        const f32x4 dco = *(const f32x4*)(a.in[15] + g * 16 + 4 * s4);
        bf16x8 ef[8], ff[2][4], kf[2][8];
#pragma unroll
        for (int ks = 0; ks < 8; ++ks) ef[ks] = *(const bf16x8*)(E + (size_t)(16 * wave + l15) * 256 + 8 * s4 + 32 * ks);
#pragma unroll
        for (int rr = 0; rr < 2; ++rr) {
            const int r = wave + 8 * rr;
#pragma unroll
            for (int ks = 0; ks < 4; ++ks) ff[rr][ks] = *(const bf16x8*)(F + (size_t)(16 * r + l15) * 128 + 8 * s4 + 32 * ks);
#pragma unroll
            for (int q = 0; q < 8; ++q) if (rr == 1 || q < 4) {
                const int tau = r - (2 * q + (s4 >> 1)), tc = tau < 0 ? 0 : tau;
                const u32x4 kw = *(const u32x4*)(K16 + (size_t)(tc * 16 + l15) * 16 + 8 * (s4 & 1));
                kf[rr][q] = __builtin_bit_cast(bf16x8, tau < 0 ? (u32x4){0u, 0u, 0u, 0u} : kw);
            }
        }
        float Sr = 0.f, Si = 0.f;
        {
            const size_t segtok0 = (size_t)b * SEQ;
#pragma unroll
            for (int i = 0; i < 2; ++i) {
                const int t2 = tid + i * NTHREADS;
                const bf16* src = proj + (segtok0 + t2) * NIN + 2048 + g * 16;
                const u32x4 v0 = *(const u32x4*)src, v1 = *(const u32x4*)(src + 8);
                LAS unsigned char* dst = lds + (t2 >> 4) * 528 + (t2 & 15) * 32;
                *(LAS u32x4*)dst = v0; *(LAS u32x4*)(dst + 16) = v1;
            }
        }
        __syncthreads();
        for (int seg = 0; seg < 4; ++seg) {
            const size_t segtok0 = (size_t)b * SEQ + seg * 1024;
            LAS unsigned char* useg = lds + (seg & 1) * 33792;
            LAS unsigned char* unext = lds + ((seg + 1) & 1) * 33792;
            u32x4 pf[4];
            if (seg < 3) {
#pragma unroll
                for (int i = 0; i < 2; ++i) {
                    const int t2 = tid + i * NTHREADS;
                    const bf16* src = proj + (segtok0 + 1024 + t2) * NIN + 2048 + g * 16;
                    pf[2 * i] = *(const u32x4*)src; pf[2 * i + 1] = *(const u32x4*)(src + 8);
                }
            }
            {
                f32x4 acc[4];
#pragma unroll
                for (int nb = 0; nb < 4; ++nb) acc[nb] = (f32x4){0.f, 0.f, 0.f, 0.f};
#pragma unroll
                for (int ks = 0; ks < 8; ++ks) {
#pragma unroll
                    for (int nb = 0; nb < 4; ++nb) {
                        const bf16x8 uf = *(const LAS bf16x8*)(useg + (16 * nb + l15) * 528 + (2 * ks + (s4 >> 1)) * 32 + 16 * (s4 & 1));
                        acc[nb] = __builtin_amdgcn_mfma_f32_16x16x32_bf16(ef[ks], uf, acc[nb], 0, 0, 0);
                    }
                    if (ks & 1) __builtin_amdgcn_sched_barrier(0);
                }
#pragma unroll
                for (int nb = 0; nb < 4; ++nb)
#pragma unroll
                    for (int j = 0; j < 4; ++j) lbuf[(16 * wave + 4 * s4 + j) * 65 + 16 * nb + l15] = acc[nb][j];
            }
            __syncthreads();
            if (wave == 0) {
                LAS bf16* sb16 = (LAS bf16*)sb;
#pragma unroll 1
                for (int s8 = 0; s8 < 64; s8 += 8) {
                    float lr[8], li[8];
#pragma unroll
                    for (int k = 0; k < 8; ++k) { lr[k] = lbuf[lane * 65 + s8 + k]; li[k] = lbuf[(64 + lane) * 65 + s8 + k]; }
#pragma unroll
                    for (int k = 0; k < 8; ++k) {
                        sb16[(s8 + k) * 136 + lane] = (bf16)f2bf(Sr); sb16[(s8 + k) * 136 + 64 + lane] = (bf16)f2bf(Si);
                        const float nr = l16r * Sr - l16i * Si + lr[k], ni = l16r * Si + l16i * Sr + li[k];
                        Sr = nr; Si = ni;
                    }
                }
            }
            __syncthreads();
#pragma unroll
            for (int rr = 0; rr < 2; ++rr) {
                const int r = wave + 8 * rr;
                f32x4 acc[4];
#pragma unroll
                for (int nb = 0; nb < 4; ++nb) acc[nb] = (f32x4){0.f, 0.f, 0.f, 0.f};
#pragma unroll
                for (int ks = 0; ks < 4; ++ks) {
#pragma unroll
                    for (int nb = 0; nb < 4; ++nb) {
                        const bf16x8 sf = *(const LAS bf16x8*)(sb + (16 * nb + l15) * 272 + (32 * ks + 8 * s4) * 2);
                        acc[nb] = __builtin_amdgcn_mfma_f32_16x16x32_bf16(ff[rr][ks], sf, acc[nb], 0, 0, 0);
                    }
                    if (ks & 1) __builtin_amdgcn_sched_barrier(0);
                }
#pragma unroll
                for (int q = 0; q < 8; ++q) {
                    if ((rr == 1 || q < 4) && 2 * q <= r) {
#pragma unroll
                        for (int nb = 0; nb < 4; ++nb) {
                            const bf16x8 uf = *(const LAS bf16x8*)(useg + (16 * nb + l15) * 528 + (2 * q + (s4 >> 1)) * 32 + 16 * (s4 & 1));
                            acc[nb] = __builtin_amdgcn_mfma_f32_16x16x32_bf16(kf[rr][q], uf, acc[nb], 0, 0, 0);
                        }
                    }
                    if (q & 1) __builtin_amdgcn_sched_barrier(0);
                }
#pragma unroll
                for (int nb = 0; nb < 4; ++nb) {
                    const int sc = 16 * nb + l15;
                    const u32x2 uw = *(const LAS u32x2*)(useg + sc * 528 + r * 32 + 8 * s4);
                    const float y0 = acc[nb][0] + dco[0] * bflo(uw[0]), y1 = acc[nb][1] + dco[1] * bfhi(uw[0]), y2 = acc[nb][2] + dco[2] * bflo(uw[1]), y3 = acc[nb][3] + dco[3] * bfhi(uw[1]);
                    u32x2 o; o[0] = pk2(gelu_tanh(y0), gelu_tanh(y1)); o[1] = pk2(gelu_tanh(y2), gelu_tanh(y3));
                    *(u32x2*)(Z + (segtok0 + 16 * sc + r) * 1024 + g * 16 + 4 * s4) = o;
                }
            }
            if (seg < 3) {
#pragma unroll
                for (int i = 0; i < 2; ++i) {
                    const int t2 = tid + i * NTHREADS;
                    LAS unsigned char* dst = unext + (t2 >> 4) * 528 + (t2 & 15) * 32;
                    *(LAS u32x4*)dst = pf[2 * i]; *(LAS u32x4*)(dst + 16) = pf[2 * i + 1];
                }
            }
            __syncthreads();
        }
    }
}

__device__ __forceinline__ void ph_ysnorm(const Args& a) {
    int tid_ = threadIdx.x; asm volatile("" : "+v"(tid_));
    const int tid = tid_, lane = tid & 63, wave = tid >> 6;
    const int gw = blockIdx.x * NWAVES + wave, NGW = gridDim.x * NWAVES;
    const bf16* ys = (const bf16*)(a.ws + WS_YS); bf16* Y = (bf16*)(a.ws + WS_Y); const float* part = (const float*)(a.ws + WS_PARTS);
    for (int m = gw; m < NTOK; m += NGW) {
        float s = (lane < 16) ? part[(size_t)m * 16 + lane] : 0.f;
        const float rinv = 1.0f / sqrtf(wave_sum(s) * (1.0f / 1024.0f) + EPS);
#pragma unroll
        for (int j = 0; j < 2; ++j) {
            const u32x4 w = *(const u32x4*)(ys + (size_t)m * 1024 + 8 * (lane + 64 * j));
            u32x4 o;
#pragma unroll
            for (int e = 0; e < 4; ++e) o[e] = pk2(bflo(w[e]) * rinv, bfhi(w[e]) * rinv);
            *(u32x4*)(Y + (size_t)m * 2048 + 1024 + 8 * (lane + 64 * j)) = o;
        }
    }
}

__device__ __forceinline__ unsigned enc_key(float v) { const unsigned b = __builtin_bit_cast(unsigned, v); return b ^ ((b >> 31) ? 0xffffffffu : 0x80000000u); }
__device__ __forceinline__ float dec_key(unsigned o) { const unsigned b = (o & 0x80000000u) ? (o ^ 0x80000000u) : ~o; return __builtin_bit_cast(float, b); }
template <int CTRL> __device__ __forceinline__ unsigned dpp_u(unsigned v) { return (unsigned)__builtin_amdgcn_update_dpp(0, (int)v, CTRL, 0xf, 0xf, false); }
__device__ __forceinline__ unsigned row_umax(unsigned v) {
    unsigned t;
    t = dpp_u<0x128>(v); v = t > v ? t : v;
    t = dpp_u<0x124>(v); v = t > v ? t : v;
    t = dpp_u<0x122>(v); v = t > v ? t : v;
    t = dpp_u<0x121>(v); v = t > v ? t : v;
    return v;
}
#define CSWAP(x, y) do { const unsigned hi_ = (x) > (y) ? (x) : (y), lo_ = (x) > (y) ? (y) : (x); (x) = hi_; (y) = lo_; } while (0)
__device__ __forceinline__ void ph_topk(const Args& a, LAS unsigned char* lds) {
    int tid_ = threadIdx.x; asm volatile("" : "+v"(tid_));
    const int tid = tid_, lane = tid & 63, wave = __builtin_amdgcn_readfirstlane(tid >> 6), l15 = lane & 15, s4 = lane >> 4;
    const bf16* qp = (const bf16*)(a.ws + WS_Z);
    const bf16* keysb = (const bf16*)(a.ws + WS_KEYS);
    int* idxo = (int*)(a.ws + WS_YS); float* gateo = (float*)(a.ws + WS_YS + 4 * MiB);
    LAS float* sc = (LAS float*)(lds + wave * 16448);
    LAS unsigned* lst = (LAS unsigned*)(lds + 8 * 16448) + wave * 128 + s4 * 32;
    const int h = wave;
    bf16x8 kf[2][8][2];
#pragma unroll
    for (int side = 0; side < 2; ++side)
#pragma unroll
        for (int nbl = 0; nbl < 8; ++nbl)
#pragma unroll
            for (int ks = 0; ks < 2; ++ks) kf[side][nbl][ks] = *(const bf16x8*)(keysb + ((size_t)((h * 2 + side) * 128 + 16 * nbl + l15)) * 64 + 32 * ks + 8 * s4);
    for (int item = blockIdx.x; item < NTOK / 32; item += gridDim.x) {
#pragma unroll 1
        for (int sub = 0; sub < 2; ++sub) {
            const int t0 = item * 32 + sub * 16;
            bf16x8 qf[2][2];
#pragma unroll
            for (int side = 0; side < 2; ++side)
#pragma unroll
                for (int ks = 0; ks < 2; ++ks) qf[side][ks] = *(const bf16x8*)(qp + (size_t)(t0 + l15) * 1024 + h * 128 + side * 64 + 32 * ks + 8 * s4);
#pragma unroll
            for (int side = 0; side < 2; ++side)
#pragma unroll
                for (int nbl = 0; nbl < 8; ++nbl) {
                    f32x4 c = {0.f, 0.f, 0.f, 0.f};
#pragma unroll
                    for (int ks = 0; ks < 2; ++ks) c = __builtin_amdgcn_mfma_f32_16x16x32_bf16(qf[side][ks], kf[side][nbl][ks], c, 0, 0, 0);
#pragma unroll
                    for (int j = 0; j < 4; ++j) sc[(4 * s4 + j) * 257 + side * 128 + 16 * nbl + l15] = c[j];
                }
            asm volatile("s_waitcnt lgkmcnt(0)" ::: "memory");
#pragma unroll 1
            for (int tt = 0; tt < 4; ++tt) {
                const int tl = tt * 4 + s4; const LAS float* sr = sc + tl * 257;
                unsigned top[2];
#pragma unroll
                for (int side = 0; side < 2; ++side) {
                    unsigned v[8];
#pragma unroll
                    for (int k = 0; k < 8; ++k) v[k] = (enc_key(sr[side * 128 + l15 + 16 * k]) & ~127u) | (unsigned)(127 - (l15 + 16 * k));
                    CSWAP(v[0], v[1]); CSWAP(v[2], v[3]); CSWAP(v[4], v[5]); CSWAP(v[6], v[7]);
                    CSWAP(v[0], v[2]); CSWAP(v[1], v[3]); CSWAP(v[4], v[6]); CSWAP(v[5], v[7]);
                    CSWAP(v[1], v[2]); CSWAP(v[5], v[6]); CSWAP(v[0], v[4]); CSWAP(v[3], v[7]);
                    CSWAP(v[1], v[5]); CSWAP(v[2], v[6]);
                    CSWAP(v[1], v[4]); CSWAP(v[3], v[6]);
                    CSWAP(v[2], v[4]); CSWAP(v[3], v[5]);
                    CSWAP(v[3], v[4]);
                    unsigned mine = 0u;
#pragma unroll
                    for (int it = 0; it < 16; ++it) {
                        const unsigned m = row_umax(v[0]);
                        const bool win = v[0] == m;
#pragma unroll
                        for (int k = 0; k < 7; ++k) v[k] = win ? v[k + 1] : v[k];
                        v[7] = win ? 0u : v[7];
                        mine = (l15 == it) ? m : mine;
                    }
                    top[side] = mine;
                }
                lst[l15] = top[0]; lst[16 + l15] = top[1];
                asm volatile("s_waitcnt lgkmcnt(0)" ::: "memory");
                const float s1 = dec_key(top[0] & ~127u);
                unsigned c[16];
#pragma unroll
                for (int q = 0; q < 4; ++q) {
                    const u32x4 w = *(const LAS u32x4*)(lst + 16 + 4 * q);
#pragma unroll
                    for (int k = 0; k < 4; ++k) c[4 * q + k] = (enc_key(s1 + dec_key(w[k] & ~127u)) & ~255u) | (unsigned)(255 - (l15 * 16 + 4 * q + k));
                }
                unsigned mine = 0u;
#pragma unroll
                for (int it = 0; it < 16; ++it) {
                    const unsigned m = row_umax(c[0]);
                    const bool win = c[0] == m;
#pragma unroll
                    for (int k = 0; k < 15; ++k) c[k] = win ? c[k + 1] : c[k];
                    c[15] = win ? 0u : c[15];
                    mine = (l15 == it) ? m : mine;
                }
                const float val = dec_key(mine & ~255u);
                float vm = val;
                { float t;
                  t = __builtin_bit_cast(float, dpp_u<0x128>(__builtin_bit_cast(unsigned, vm))); vm = fmaxf(vm, t);
                  t = __builtin_bit_cast(float, dpp_u<0x124>(__builtin_bit_cast(unsigned, vm))); vm = fmaxf(vm, t);
                  t = __builtin_bit_cast(float, dpp_u<0x122>(__builtin_bit_cast(unsigned, vm))); vm = fmaxf(vm, t);
                  t = __builtin_bit_cast(float, dpp_u<0x121>(__builtin_bit_cast(unsigned, vm))); vm = fmaxf(vm, t); }
                const float ex = __expf(val - vm);
                float sm = ex;
                { float t;
                  t = __builtin_bit_cast(float, dpp_u<0x128>(__builtin_bit_cast(unsigned, sm))); sm += t;
                  t = __builtin_bit_cast(float, dpp_u<0x124>(__builtin_bit_cast(unsigned, sm))); sm += t;
                  t = __builtin_bit_cast(float, dpp_u<0x122>(__builtin_bit_cast(unsigned, sm))); sm += t;
                  t = __builtin_bit_cast(float, dpp_u<0x121>(__builtin_bit_cast(unsigned, sm))); sm += t; }
                {
                    const int cand = 255 - (int)(mine & 255u), ia = cand >> 4, ib = cand & 15;
                    const int i1 = 127 - (int)(lst[ia] & 127u), i2 = 127 - (int)(lst[16 + ib] & 127u);
                    const int jp = h * 16 + l15;
                    const size_t o = (size_t)(t0 + tl) * 128 + (jp & 7) * 16 + (jp >> 3);
                    idxo[o] = i1 * 128 + i2; gateo[o] = ex / sm;
                }
                asm volatile("s_waitcnt lgkmcnt(0)" ::: "memory");
            }
        }
    }
}

__device__ __forceinline__ float cvt_ub(unsigned w, int k) { return (float)((w >> (8 * k)) & 0xffu); }
template <int CTRL> __device__ __forceinline__ float dpp_f(float v) { return __builtin_bit_cast(float, __builtin_amdgcn_update_dpp(0, __builtin_bit_cast(int, v), CTRL, 0xf, 0xf, false)); }
#define PP_LOAD_IDX(ei, tok) do { _Pragma("unroll") for (int q_ = 0; q_ < 4; ++q_) { const u32x4 t_ = *(const u32x4*)(idx + (size_t)(tok) * 128 + pr * 16 + 4 * q_); \
        ei[4 * q_] = (int)t_[0]; ei[4 * q_ + 1] = (int)t_[1]; ei[4 * q_ + 2] = (int)t_[2]; ei[4 * q_ + 3] = (int)t_[3]; } } while (0)
#define PP_G8(ub, ei, o8) do { _Pragma("unroll") for (int i_ = 0; i_ < 8; ++i_) ub[i_] = *(const u32x4*)(slab + ((unsigned)ei[(o8) + i_] * 128u + coff)); } while (0)
#define PU_LOAD_H(hx, tok) do { hx[0] = *(const u32x4*)(h2b + (size_t)(tok) * 2048 + 128 * s + 16 * c); hx[1] = *(const u32x4*)(h2b + (size_t)(tok) * 2048 + 128 * s + 16 * c + 8); } while (0)
template <int CTRL> __device__ __forceinline__ int dpp_i(int v) { return __builtin_amdgcn_update_dpp(0, v, CTRL, 0xf, 0xf, false); }
#define PU_QUANT(hx, hq, hs) do { \
        float f_[16]; _Pragma("unroll") for (int q_ = 0; q_ < 2; ++q_) _Pragma("unroll") for (int e_ = 0; e_ < 4; ++e_) { f_[8 * q_ + 2 * e_] = bflo(hx[q_][e_]); f_[8 * q_ + 2 * e_ + 1] = bfhi(hx[q_][e_]); } \
        float m_ = 0.f; _Pragma("unroll") for (int k_ = 0; k_ < 16; ++k_) m_ = fmaxf(m_, fabsf(f_[k_])); \
        m_ = fmaxf(m_, dpp_f<0xB1>(m_)); m_ = fmaxf(m_, dpp_f<0x4E>(m_)); m_ = fmaxf(m_, dpp_f<0x141>(m_)); m_ = fmaxf(m_, 1e-30f); \
        const float iv_ = 127.0f / m_; hs = m_ * (1.0f / 127.0f); \
        _Pragma("unroll") for (int q_ = 0; q_ < 4; ++q_) { \
            const int a0_ = (int)rintf(f_[4 * q_] * iv_), a1_ = (int)rintf(f_[4 * q_ + 1] * iv_), a2_ = (int)rintf(f_[4 * q_ + 2] * iv_), a3_ = (int)rintf(f_[4 * q_ + 3] * iv_); \
            hq[q_] = (int)(((unsigned)a0_ & 0xffu) | (((unsigned)a1_ & 0xffu) << 8) | (((unsigned)a2_ & 0xffu) << 16) | ((unsigned)a3_ << 24)); } } while (0)
#define PU_C8(ub, hq, hs, res) do { \
        _Pragma("unroll") for (int i_ = 0; i_ < 8; ++i_) { \
            int d_ = 0; \
            _Pragma("unroll") for (int q_ = 0; q_ < 4; ++q_) d_ = __builtin_amdgcn_sdot4((int)ub[i_][q_], hq[q_], d_, false); \
            d_ += dpp_i<0xB1>(d_); d_ += dpp_i<0x4E>(d_); d_ += dpp_i<0x141>(d_); \
            res = (c == i_) ? (float)d_ * hs : res; } } while (0)
#define PU_STORE(tok, k_, r0, r1) do { LAS float* lp_ = keep + (k_) * 128 + lane; \
        if (pass == 0) { lp_[0] = r0; lp_[64] = r1; } \
        else { float* po_ = pu + ((size_t)x * NTOK + (tok)) * 128 + pr * 16 + c; po_[0] = r0 + lp_[0]; po_[8] = r1 + lp_[64]; } } while (0)
__device__ __forceinline__ void ph_peer_u(const Args& a, LAS unsigned char* lds) {
    int tid_ = threadIdx.x; asm volatile("" : "+v"(tid_));
    const int tid = tid_, lane = tid & 63, wave = tid >> 6, pr = lane >> 3, c = lane & 7;
    const bf16* h2b = (const bf16*)(a.ws + WS_AB);
    const unsigned char* Uq = a.ws + WS_UB;
    const int* idx = (const int*)(a.ws + WS_YS);
    float* pu = (float*)(a.ws + WS_PU);
    const int x = blockIdx.x & 7, nbx = gridDim.x >> 3, bi = blockIdx.x >> 3;
    const int tstride = nbx * NWAVES, tfirst = bi * NWAVES + wave, ntok = NTOK / tstride;
    LAS float* keep = (LAS float*)(lds + wave * 16384);
    const unsigned coff = 16u * (unsigned)c;
    for (int pass = 0; pass < 2; ++pass) {
        const int s = x + 8 * pass;
        const unsigned char* slab = Uq + (size_t)s * PE * 128;
        int eA[16], eB[16]; u32x4 ub0[8], ub1[8]; u32x4 hA[2], hB[2];
        PP_LOAD_IDX(eA, tfirst);
        PP_G8(ub0, eA, 0); PU_LOAD_H(hA, tfirst);
        PP_LOAD_IDX(eB, tfirst + tstride);
        for (int k = 0; k < ntok; k += 2) {
            const int tokA = tfirst + k * tstride, tokB = tokA + tstride;
            const bool more = k + 2 < ntok;
            float r0 = 0.f, r1 = 0.f; int hq[4]; float hs;
            PP_G8(ub1, eA, 8);
            if (more) PP_LOAD_IDX(eA, tokA + 2 * tstride);
            PU_QUANT(hA, hq, hs);
            PU_C8(ub0, hq, hs, r0);
            PP_G8(ub0, eB, 0); PU_LOAD_H(hB, tokB);
            PU_C8(ub1, hq, hs, r1);
            PU_STORE(tokA, k, r0, r1);
            r0 = 0.f; r1 = 0.f;
            PP_G8(ub1, eB, 8);
            if (more) PP_LOAD_IDX(eB, tokB + 2 * tstride);
            PU_QUANT(hB, hq, hs);
            PU_C8(ub0, hq, hs, r0);
            if (more) { PP_G8(ub0, eA, 0); PU_LOAD_H(hA, tokA + 2 * tstride); }
            PU_C8(ub1, hq, hs, r1);
            PU_STORE(tokB, k + 1, r0, r1);
        }
    }
}
__device__ __forceinline__ void ph_peer_w(const Args& a) {
    int tid_ = threadIdx.x; asm volatile("" : "+v"(tid_));
    const int tid = tid_, lane = tid & 63, wave = tid >> 6;
    const float* part = (const float*)(a.ws + WS_PART2);
    const float* su = (const float*)(a.ws + WS_QSC); const float* sv = su + PE;
    const int* idx = (const int*)(a.ws + WS_YS); const float* gate = (const float*)(a.ws + WS_YS + 4 * MiB);
    const float* pu = (const float*)(a.ws + WS_PU);
    unsigned char* wq = (unsigned char*)(a.ws + WS_WP); float* wsc = (float*)(a.ws + WS_WSUM);
    for (int tok = blockIdx.x * NWAVES + wave; tok < NTOK; tok += gridDim.x * NWAVES) {
        const float ps = (lane < 32) ? part[(size_t)tok * 32 + lane] : 0.f;
        const float rinv = 1.0f / sqrtf(wave_sum(ps) * (1.0f / 2048.0f) + EPS);
        float w[2]; float mx = 0.f;
#pragma unroll
        for (int hh = 0; hh < 2; ++hh) {
            const int pos = lane + 64 * hh;
            float d = 0.f;
#pragma unroll
            for (int s = 0; s < 8; ++s) d += pu[((size_t)s * NTOK + tok) * 128 + pos];
            const int e = idx[(size_t)tok * 128 + pos];
            w[hh] = gate[(size_t)tok * 128 + pos] * gelu_tanh(d * rinv * su[e]) * sv[e];
            mx = fmaxf(mx, fabsf(w[hh]));
        }
#pragma unroll
        for (int o = 1; o < 64; o <<= 1) mx = fmaxf(mx, __shfl_xor(mx, o));
        mx = fmaxf(mx, 1e-30f);
        const float iv = 127.0f / mx;
#pragma unroll
        for (int hh = 0; hh < 2; ++hh) wq[(size_t)tok * 128 + lane + 64 * hh] = (unsigned char)((int)rintf(w[hh] * iv) & 0xff);
        if (lane == 0) wsc[tok] = mx * (1.0f / 127.0f);
    }
}
#define PV_LOAD_W(wv, tok) do { wv = *(const u32x4*)(wq + (size_t)(tok) * 128 + pr * 16); } while (0)
#define PV_G4(r0, r1, r2, r3, wd, acc) do { _Pragma("unroll") for (int q_ = 0; q_ < 4; ++q_) { \
        const unsigned l01_ = __builtin_amdgcn_perm(r1[q_], r0[q_], 0x05010400u), l23_ = __builtin_amdgcn_perm(r3[q_], r2[q_], 0x05010400u); \
        const unsigned h01_ = __builtin_amdgcn_perm(r1[q_], r0[q_], 0x07030602u), h23_ = __builtin_amdgcn_perm(r3[q_], r2[q_], 0x07030602u); \
        acc[4 * q_ + 0] = __builtin_amdgcn_sdot4((int)__builtin_amdgcn_perm(l23_, l01_, 0x05040100u), (int)(wd), acc[4 * q_ + 0], false); \
        acc[4 * q_ + 1] = __builtin_amdgcn_sdot4((int)__builtin_amdgcn_perm(l23_, l01_, 0x07060302u), (int)(wd), acc[4 * q_ + 1], false); \
        acc[4 * q_ + 2] = __builtin_amdgcn_sdot4((int)__builtin_amdgcn_perm(h23_, h01_, 0x05040100u), (int)(wd), acc[4 * q_ + 2], false); \
        acc[4 * q_ + 3] = __builtin_amdgcn_sdot4((int)__builtin_amdgcn_perm(h23_, h01_, 0x07060302u), (int)(wd), acc[4 * q_ + 3], false); } } while (0)
#define PV_C8(vb, wv, o8, acc) do { PV_G4(vb[0], vb[1], vb[2], vb[3], wv[(o8) / 4], acc); PV_G4(vb[4], vb[5], vb[6], vb[7], wv[(o8) / 4 + 1], acc); } while (0)
#define PV_FINISH(acc, tok) do { \
        int r8_[8]; _Pragma("unroll") for (int k_ = 0; k_ < 8; ++k_) { const int m_ = b2 ? acc[k_ + 8] : acc[k_], o_ = b2 ? acc[k_] : acc[k_ + 8]; r8_[k_] = m_ + __shfl_xor(o_, 32); } \
        int r4_[4]; _Pragma("unroll") for (int k_ = 0; k_ < 4; ++k_) { const int m_ = b1 ? r8_[k_ + 4] : r8_[k_], o_ = b1 ? r8_[k_] : r8_[k_ + 4]; r4_[k_] = m_ + __shfl_xor(o_, 16); } \
        int r2_[2]; _Pragma("unroll") for (int k_ = 0; k_ < 2; ++k_) { const int m_ = b0 ? r4_[k_ + 2] : r4_[k_], o_ = b0 ? r4_[k_] : r4_[k_ + 2]; r2_[k_] = m_ + __shfl_xor(o_, 8); } \
        const float ws_ = wsc[(tok)]; \
        const size_t ho_ = (size_t)(tok) * 2048 + 128 * s + 16 * c + 2 * pr; \
        const unsigned hx_ = *(const unsigned*)(h2b + ho_); \
        const float o0_ = bflo(hx_) + (float)r2_[0] * ws_, o1_ = bfhi(hx_) + (float)r2_[1] * ws_; \
        *(f32x2*)(h3 + ho_) = (f32x2){o0_, o1_}; \
        const float ss_ = wave_sum(o0_ * o0_ + o1_ * o1_); \
        if (lane == 0) partf[(size_t)(tok) * 16 + s] = ss_; \
        _Pragma("unroll") for (int k_ = 0; k_ < 16; ++k_) acc[k_] = 0; } while (0)
__device__ __forceinline__ void ph_peer_v(const Args& a) {
    int tid_ = threadIdx.x; asm volatile("" : "+v"(tid_));
    const int tid = tid_, lane = tid & 63, wave = tid >> 6, pr = lane >> 3, c = lane & 7;
    const bf16* h2b = (const bf16*)(a.ws + WS_AB); float* h3 = (float*)(a.ws + WS_H);
    const unsigned char* Vq = a.ws + WS_VB;
    const int* idx = (const int*)(a.ws + WS_YS);
    const unsigned char* wq = (const unsigned char*)(a.ws + WS_WP); const float* wsc = (const float*)(a.ws + WS_WSUM);
    float* partf = (float*)(a.ws + WS_PARTF);
    const int x = blockIdx.x & 7, nbx = gridDim.x >> 3, bi = blockIdx.x >> 3;
    const bool b2 = (pr & 4) != 0, b1 = (pr & 2) != 0, b0 = (pr & 1) != 0;
    const int tstride = nbx * NWAVES, tfirst = bi * NWAVES + wave, ntok = NTOK / tstride;
    const unsigned coff = 16u * (unsigned)c;
    for (int pass = 0; pass < 2; ++pass) {
        const int s = x + 8 * pass;
        const unsigned char* slab = Vq + (size_t)s * PE * 128;
        int eA[16], eB[16]; u32x4 ub0[8], ub1[8]; u32x4 wA, wB; int acc[16];
#pragma unroll
        for (int k = 0; k < 16; ++k) acc[k] = 0;
        PP_LOAD_IDX(eA, tfirst);
        PP_G8(ub0, eA, 0); PV_LOAD_W(wA, tfirst);
        PP_LOAD_IDX(eB, tfirst + tstride);
        for (int k = 0; k < ntok; k += 2) {
            const int tokA = tfirst + k * tstride, tokB = tokA + tstride;
            const bool more = k + 2 < ntok;
            PP_G8(ub1, eA, 8);
            if (more) PP_LOAD_IDX(eA, tokA + 2 * tstride);
            PV_C8(ub0, wA, 0, acc);
            PP_G8(ub0, eB, 0); PV_LOAD_W(wB, tokB);
            PV_C8(ub1, wA, 8, acc);
            PV_FINISH(acc, tokA);
            PP_G8(ub1, eB, 8);
            if (more) PP_LOAD_IDX(eB, tokB + 2 * tstride);
            PV_C8(ub0, wB, 0, acc);
            if (more) { PP_G8(ub0, eA, 0); PV_LOAD_W(wA, tokA + 2 * tstride); }
            PV_C8(ub1, wB, 8, acc);
            PV_FINISH(acc, tokB);
        }
    }
}
__device__ __forceinline__ void ph_final(const Args& a) {
    int tid_ = threadIdx.x; asm volatile("" : "+v"(tid_));
    const int tid = tid_, lane = tid & 63, wave = tid >> 6;
    const float* h3 = (const float*)(a.ws + WS_H); const float* partf = (const float*)(a.ws + WS_PARTF); const float* gfin = a.in[30];
    const int step = gridDim.x * NWAVES;
#define FN_LOAD(v, ps, tok) do { ps = (lane < 16) ? partf[(size_t)(tok) * 16 + lane] : 0.f; \
        _Pragma("unroll") for (int j_ = 0; j_ < 8; ++j_) v[j_] = __builtin_nontemporal_load((const f32x4*)(h3 + (size_t)(tok) * 2048 + 4 * (lane + 64 * j_))); } while (0)
#define FN_PROC(v, ps, tok) do { const float rf_ = 1.0f / sqrtf(wave_sum(ps) * (1.0f / 2048.0f) + EPS); \
        _Pragma("unroll") for (int j_ = 0; j_ < 8; ++j_) { const f32x4 g_ = *(const f32x4*)(gfin + 4 * (lane + 64 * j_)); \
            __builtin_nontemporal_store(v[j_] * g_ * rf_, (f32x4*)(a.out + (size_t)(tok) * 2048 + 4 * (lane + 64 * j_))); } } while (0)
    f32x4 va[8], vb[8]; float pa = 0.f, pb = 0.f;
    int tok = blockIdx.x * NWAVES + wave;
    if (tok < NTOK) FN_LOAD(va, pa, tok);
    for (; tok < NTOK; tok += 2 * step) {
        const int tn = tok + step;
        if (tn < NTOK) FN_LOAD(vb, pb, tn);
        FN_PROC(va, pa, tok);
        if (tn < NTOK) {
            if (tn + step < NTOK) FN_LOAD(va, pa, tn + step);
            FN_PROC(vb, pb, tn);
        }
    }
#undef FN_LOAD
#undef FN_PROC
}

#define XB_TMO      128
#define XB_XCNT(j)  (256  + 64 * (j))
#define XB_XSUB(j)  (1280 + 64 * (j))
#define XB_XGEN(j)  (2304 + 64 * (j))
#define XB_TOP      3328
#define XB_TOPGEN   3392
#define XCD_BAR_WORDS 3456
#define XB_SPIN_CAP (1u << 18)
__device__ __forceinline__ unsigned xb_ld(unsigned* p)              { return __hip_atomic_load(p, __ATOMIC_RELAXED, __HIP_MEMORY_SCOPE_AGENT); }
__device__ __forceinline__ unsigned xb_add(unsigned* p, unsigned v) { return __hip_atomic_fetch_add(p, v, __ATOMIC_RELAXED, __HIP_MEMORY_SCOPE_AGENT); }
__device__ __forceinline__ unsigned xb_xcc_id() { return (unsigned)__builtin_amdgcn_s_getreg((3 << 11) | 20) & 0xFu; }
#define XB_SPIN(cond, bar) do { unsigned _sp = 0; while (cond) { __builtin_amdgcn_s_sleep(1); \
    if ((++_sp & 255u) == 0u) { if (xb_ld(&(bar)[XB_TMO])) break; if (_sp > XB_SPIN_CAP) { atomicAdd(&(bar)[XB_TMO], 1u); break; } } } } while (0)
struct XcdBarrier { unsigned* bar; unsigned x; volatile LAS unsigned* st; };
__device__ __forceinline__ XcdBarrier xcd_barrier_post(unsigned* bar, volatile LAS unsigned* st) {
    XcdBarrier b; b.bar = bar; b.x = xb_xcc_id(); b.st = st;
    if (threadIdx.x == 0) (void)xb_add(&bar[XB_XCNT(b.x)], 1u);
    return b;
}
__device__ __forceinline__ void xcd_barrier_complete(unsigned* bar, unsigned x, unsigned& nloc, unsigned& nx) {
    const unsigned G = gridDim.x * gridDim.y * gridDim.z;
    unsigned sum, cnt, mine, sp = 0u;
    for (;;) {
        sum = 0u; cnt = 0u; mine = 0u;
#pragma unroll
        for (unsigned j = 0; j < 16; ++j) { const unsigned c = xb_ld(&bar[XB_XCNT(j)]); sum += c; cnt += (c > 0u) ? 1u : 0u; mine = (j == x) ? c : mine; }
        if (sum == G) break;
        __builtin_amdgcn_s_sleep(1);
        if ((++sp & 255u) == 0u) { if (xb_ld(&bar[XB_TMO])) break; if (sp > XB_SPIN_CAP) { atomicAdd(&bar[XB_TMO], 1u); break; } }
    }
    nloc = mine > 0u ? mine : 1u; nx = cnt > 0u ? cnt : 1u;
}
__device__ __forceinline__ void xcd_barrier(const XcdBarrier& b) {
    asm volatile("s_waitcnt vmcnt(0)" ::: "memory");
    __syncthreads();
    if (threadIdx.x == 0) {
        unsigned* bar = b.bar;
        __builtin_amdgcn_s_waitcnt(0);
        unsigned nloc = b.st[0], nx = b.st[1];
        if (nloc == 0u) { xcd_barrier_complete(bar, b.x, nloc, nx); b.st[0] = nloc; b.st[1] = nx; }
        const unsigned old = xb_add(&bar[XB_XSUB(b.x)], 1u);
        const unsigned gen = old / nloc;
        if (old + 1u == (gen + 1u) * nloc) {
            __builtin_amdgcn_fence(__ATOMIC_RELEASE, "agent");
            asm volatile("s_waitcnt vmcnt(0)" ::: "memory");
            const unsigned og = xb_add(&bar[XB_TOP], 1u);
            const unsigned tg = og / nx;
            if (og + 1u == (tg + 1u) * nx) xb_add(&bar[XB_TOPGEN], 1u);
            else XB_SPIN(xb_ld(&bar[XB_TOPGEN]) == tg, bar);
            __builtin_amdgcn_fence(__ATOMIC_ACQUIRE, "agent");
            xb_add(&bar[XB_XGEN(b.x)], 1u);
            asm volatile("s_waitcnt vmcnt(0)" ::: "memory");
        } else {
            XB_SPIN(xb_ld(&bar[XB_XGEN(b.x)]) == gen, bar);
            __builtin_amdgcn_fence(__ATOMIC_ACQUIRE, "agent");
            asm volatile("s_waitcnt vmcnt(0)" ::: "memory");
        }
    }
    __syncthreads();
}

constexpr int MISC_OFF = LDS_BYTES - 128;
constexpr size_t CTL_ZERO_BYTES = 65536;
__global__ void __launch_bounds__(NTHREADS, 2) mk_fwd(Args a) {
    extern __shared__ __attribute__((aligned(16))) unsigned char lds_raw[];
    LAS unsigned char* lds = (LAS unsigned char*)lds_raw;
    unsigned char* ws = a.ws;
    for (int u = threadIdx.x; u < 32; u += NTHREADS) ((LAS unsigned*)(lds + MISC_OFF))[u] = 0u;
    __syncthreads();
    (void)xcd_barrier_post((unsigned*)(ws + WS_CTL), (volatile LAS unsigned*)(lds + MISC_OFF) + 8);
#define GRID_BAR() do { XcdBarrier bar_; bar_.bar = (unsigned*)(a.ws + WS_CTL); bar_.x = xb_xcc_id(); bar_.st = (volatile LAS unsigned*)(lds + MISC_OFF) + 8; xcd_barrier(bar_); } while (0)
    ph_prologue(a, lds);
    GRID_BAR();
    {
        { Epi<0> E{nullptr, nullptr, (bf16*)(ws + WS_PROJ), NIN, 1.0f, nullptr, 0, nullptr, nullptr, nullptr, nullptr, 0};
          run_gemm(lds, (const bf16*)(ws + WS_AB), (const bf16*)(ws + WS_WIN), NTOK, NIN, 2048, E); }
        { Epi<0> E{nullptr, nullptr, (bf16*)(ws + WS_KV), 4096, 1.0f, nullptr, 0, nullptr, nullptr, nullptr, nullptr, 0};
          run_gemm(lds, (const bf16*)(ws + WS_MEMN), (const bf16*)(ws + WS_WKV), NMEMTOK, 4096, 2048, E, 128); }
        if (blockIdx.x >= 160) quant_rows(a, ((int)blockIdx.x - 160) * 64, ((int)blockIdx.x - 160) * 64 + 64);
    }
    GRID_BAR();
    ph_conv(a, lds);
    ph_s5(a, lds);
    GRID_BAR();
    {
        { Epi<1> E{nullptr, nullptr, (bf16*)(ws + WS_Y), 2048, 1.0f, nullptr, 0, (const bf16*)(ws + WS_Z), nullptr, nullptr, (float*)(ws + WS_PARTS), 16};
          run_gemm(lds, (const bf16*)(ws + WS_Z), (const bf16*)(ws + WS_WGLU), NTOK, 1024, 1024, E); }
        const bf16* kv = (const bf16*)(ws + WS_KV);
        for (int bh = 0; bh < 8; ++bh) {
            const int b = bh >> 2, h = bh & 3;
            Epi<0> E{nullptr, nullptr, (bf16*)(ws + WS_G) + ((size_t)b * 1024 + h * 256) * 2048, 2048, 1.0f, nullptr, 0, nullptr, nullptr, nullptr, nullptr, 0};
            run_gemm(lds, kv + (size_t)b * 256 * 4096 + h * 512, (const bf16*)(ws + WS_WQ) + h * 512, 256, 2048, 512, E, 128 + 8 * bh, 4096, 2048);
        }
        for (int bh = 0; bh < 8; ++bh) {
            const int b = bh >> 2, h = bh & 3;
            Epi<0> E{nullptr, nullptr, (bf16*)(ws + WS_HC) + (size_t)b * 2048 * 1024 + h * 256, 1024, 1.0f, nullptr, 0, nullptr, nullptr, nullptr, nullptr, 0};
            run_gemm(lds, (const bf16*)(ws + WS_WO) + h * 512, kv + (size_t)b * 256 * 4096 + 2048 + h * 512, 2048, 256, 512, E, 192 + 8 * bh, 2048, 4096);
        }
    }
    GRID_BAR();
    {
        {
            const int c0 = (int)blockIdx.x, wg0 = (c0 & 7) * 32 + (c0 >> 3), pm0 = (wg0 >> 6) * 8 + ((wg0 & 63) & 7);
            const float* mp = (const float*)(ws + WS_PARTS);
            if (threadIdx.x < 256) {
                const int row = pm0 * 256 + (int)threadIdx.x; float s = 0.f;
#pragma unroll
                for (int i = 0; i < 16; i += 4) { const f32x4 v = *(const f32x4*)(mp + (size_t)row * 16 + i); s += (v[0] + v[1]) + (v[2] + v[3]); }
                ((LAS float*)(lds + 131072))[threadIdx.x] = 1.0f / sqrtf(s * (1.0f / 1024.0f) + EPS);
            }
            __syncthreads();
        }
        Epi<2, true> E{(const float*)(ws + WS_PARTS), lds + 131072, (bf16*)(ws + WS_AB), 2048, 1.0f, nullptr, 0, nullptr, a.in[0], nullptr, (float*)(ws + WS_PART1), 32};
        run_gemm(lds, (const bf16*)(ws + WS_Y), (const bf16*)(ws + WS_WOUT), NTOK, 2048, 2048, E);
    }
    GRID_BAR();
    {
        for (int b = 0; b < 2; ++b) {
            EpiSoftmax E{(bf16*)(ws + WS_P) + (size_t)b * SEQ * 1024, 1024, (const float*)(ws + WS_PART1) + (size_t)b * SEQ * 32, 0.044194173824159216f};
            run_gemm<EpiSoftmax, false>(lds, (const bf16*)(ws + WS_AB) + (size_t)b * SEQ * 2048, (const bf16*)(ws + WS_G) + (size_t)b * 1024 * 2048, SEQ, 1024, 2048, E, 64 * b);
        }
        if (blockIdx.x >= 128) quant_rows(a, 6144 + ((int)blockIdx.x - 128) * 104, 6144 + ((int)blockIdx.x - 128) * 104 + 104);
    }
    GRID_BAR();
    {
        for (int b = 0; b < 2; ++b) {
            Epi<2> E{nullptr, nullptr, (bf16*)(ws + WS_AB) + (size_t)b * SEQ * 2048, 2048, 1.0f, nullptr, 0, (const bf16*)(ws + WS_AB) + (size_t)b * SEQ * 2048, nullptr, nullptr, (float*)(ws + WS_PART2) + (size_t)b * SEQ * 32, 32};
            run_gemm(lds, (const bf16*)(ws + WS_P) + (size_t)b * SEQ * 1024, (const bf16*)(ws + WS_HC) + (size_t)b * 2048 * 1024, SEQ, 2048, 1024, E, 128 * b);
        }
    }
    GRID_BAR();
    {
        Epi<0> E{nullptr, nullptr, (bf16*)(ws + WS_Z), 1024, 1.0f, (const float*)(ws + WS_PART2), 32, nullptr, nullptr, nullptr, nullptr, 0};
        run_gemm(lds, (const bf16*)(ws + WS_AB), (const bf16*)(ws + WS_WPQ), NTOK, 1024, 2048, E);
        if (blockIdx.x >= 128) quant_rows(a, 19456 + ((int)blockIdx.x - 128) * 104, 19456 + ((int)blockIdx.x - 128) * 104 + 104);
    }
    GRID_BAR();
    ph_topk(a, lds);
    GRID_BAR();
    ph_peer_u(a, lds);
    GRID_BAR();
    ph_peer_w(a);
    GRID_BAR();
    ph_peer_v(a);
    GRID_BAR();
    ph_final(a);
}

extern "C" void kernel_launch(void* const* d_in, const int* in_sizes, int n_in, void* d_out, int out_size, void* d_ws, size_t ws_size, hipStream_t stream) {
    if (n_in != 31 || ws_size < WS_END) { fprintf(stderr, "kernel_launch: unexpected inputs (n_in %d, ws %zu)\n", n_in, ws_size); return; }
    static int grid = 0;
    if (grid == 0) {
        int dev = 0, cus = 0, per_cu = 0;
        if (hipGetDevice(&dev) != hipSuccess || hipDeviceGetAttribute(&cus, hipDeviceAttributeMultiprocessorCount, dev) != hipSuccess) { grid = -1; return; }
        if (hipFuncSetAttribute((const void*)mk_fwd, hipFuncAttributeMaxDynamicSharedMemorySize, LDS_BYTES) != hipSuccess) { grid = -1; return; }
        if (hipOccupancyMaxActiveBlocksPerMultiprocessor(&per_cu, (const void*)mk_fwd, NTHREADS, LDS_BYTES) != hipSuccess || per_cu < 1) { fprintf(stderr, "kernel_launch: occupancy query says %d\n", per_cu); }
        (void)hipGetLastError();
        grid = 256;
        if (cus != 256) fprintf(stderr, "kernel_launch: built for 256 CUs, device reports %d\n", cus);
    }
    if (grid < 0) return;
    (void)hipMemsetAsync((char*)d_ws + WS_CTL, 0, CTL_ZERO_BYTES, stream);
    Args a{};
    for (int i = 0; i < 31; ++i) a.in[i] = (const float*)d_in[i];
    a.out = (float*)d_out; a.ws = (unsigned char*)d_ws;
    hipLaunchKernelGGL(mk_fwd, dim3(grid), dim3(NTHREADS), LDS_BYTES, stream, a);
}
```

```cpp
#include <hip/hip_runtime.h>
#include <cstdio>
#include <cstdint>
namespace pg8 {
#define PG8_LAS __attribute__((address_space(3)))
typedef unsigned short bf16_t;
typedef short bf16x8 __attribute__((ext_vector_type(8)));
typedef float f32x4 __attribute__((ext_vector_type(4)));
typedef unsigned u32x4 __attribute__((ext_vector_type(4)));
constexpr int BM = 256, BK = 64, HALF = 128, HTB = HALF * BK * 2  , STAGE_BYTES = 8 * HTB, NXCD = 8, WGM = 8;

__host__ __device__ __forceinline__ int lds_byte(int r, int c) { const int st = (r >> 4) * 2 + (c >> 5), rr = r & 15, cc = c & 31, ob = rr * 64 + cc * 2; return st * 1024 + (ob ^ (((ob >> 9) & 1) << 5)); }
__host__ __device__ __forceinline__ void stage_rc(int b, int& R, int& C) { const int st = b / 1024, sb = b % 1024, swz = sb ^ (((sb >> 9) & 1) << 5); R = (st >> 1) * 16 + swz / 64; C = (st & 1) * 32 + (swz % 64) / 2; }
__host__ __device__ __forceinline__ int perm32(int rho) { const int n = rho >> 4, i = rho & 15; return 8 * (i >> 2) + 4 * n + (i & 3); }

struct Unit { int pm, pn; };
struct Gemm { const bf16_t* A; const bf16_t* Bt; int M, N, K, lda, ldb; };

struct StaticOrder {
    int nM, nN, nwg, G, c;
    __host__ __device__ void init(int M, int N, int G_, int c_) { nM = M / BM; nN = N / BM; nwg = nM * nN; G = G_; c = c_; }
    __host__ __device__ bool next(int i, Unit& u) const {
        const long L = (long)i * G + c; if (L >= nwg) return false;
        int wgid = (int)L; { const int q = nwg / NXCD, r = nwg % NXCD, xcd = wgid % NXCD, off = wgid / NXCD; wgid = (xcd < r ? xcd * (q + 1) : r * (q + 1) + (xcd - r) * q) + off; }
        const int nig = WGM * nN, gid = wgid / nig, fm = gid * WGM, gsz = (nM - fm) < WGM ? (nM - fm) : WGM;
        u.pm = fm + ((wgid % nig) % gsz); u.pn = (wgid % nig) / gsz; return true;
    }
    __device__ __forceinline__ void a_ready(const Unit&) const {}
    __device__ __forceinline__ void done(const Unit&) const {}
};

__device__ __forceinline__ unsigned cvt_pk_bf16(float lo, float hi) { unsigned r; asm volatile("v_cvt_pk_bf16_f32 %0, %1, %2" : "=v"(r) : "v"(lo), "v"(hi)); return r; }

template <class Epi, class Sched, bool ALIGN_EPI = false, bool SP2 = false>
__device__ __forceinline__ void gemm_phase(PG8_LAS unsigned char* lds, const Gemm g, const Sched& S, const Epi& E) {
    int tid_ = threadIdx.x; asm volatile("" : "+v"(tid_));
    const int tid = tid_, wid = __builtin_amdgcn_readfirstlane(tid >> 6), lane = tid & 63, wr = wid >> 2, wc = wid & 3, fr = lane & 15, fq = lane >> 4;
    const int K = g.K, nt = K / BK;
    unsigned voffA[2], voffB[2];
#pragma unroll
    for (int i = 0; i < 2; ++i) { int R, C; stage_rc(tid * 16 + i * 8192, R, C); const int Rb = Epi::PERM ? ((R & ~31) + perm32(R & 31)) : R;
        voffA[i] = (unsigned)(R * g.lda + C) * 2u; voffB[i] = (unsigned)(Rb * g.ldb + C) * 2u; }
    const size_t kstep = (size_t)(BK * 2);
    const size_t hstepA = (size_t)HALF * g.lda * 2, hstepB = (size_t)HALF * g.ldb * 2;
    const size_t tstepA = 2 * hstepA, tstepB = 2 * hstepB;
    const unsigned ldsw = (unsigned)wid * 1024u;
    const int aoff = lds_byte(wr * 64 + fr, fq * 8), boff = lds_byte(wc * 32 + fr, fq * 8);
#define PG8_SA(b, h) (((b) * 2 + (h)) * HTB)
#define PG8_SB(b, h) ((4 + (b) * 2 + (h)) * HTB)
#define PG8_STAGE(bufoff, gbase, voff) do { _Pragma("unroll") for (int _i = 0; _i < 2; ++_i) \
        __builtin_amdgcn_global_load_lds((const unsigned*)((const char*)(gbase) + (voff)[_i]), (PG8_LAS unsigned*)(lds + (bufoff) + ldsw + _i * 8192), 16, 0, 0); } while (0)
#define PG8_LDA(dst, b, h) do { _Pragma("unroll") for (int m = 0; m < 4; ++m) _Pragma("unroll") for (int k = 0; k < 2; ++k) dst[m][k] = *(const PG8_LAS bf16x8*)(lds + PG8_SA(b, h) + aoff + m * 2048 + k * 1024); } while (0)
#define PG8_LDB(dst, b, h) do { _Pragma("unroll") for (int n = 0; n < 2; ++n) _Pragma("unroll") for (int k = 0; k < 2; ++k) dst[n][k] = *(const PG8_LAS bf16x8*)(lds + PG8_SB(b, h) + boff + n * 2048 + k * 1024); } while (0)
#define PG8_MMA(ai, bj, At, Bt) do { __builtin_amdgcn_s_setprio(1); _Pragma("unroll") for (int m = 0; m < 4; ++m) _Pragma("unroll") for (int n = 0; n < 2; ++n) _Pragma("unroll") for (int k = 0; k < 2; ++k) \
        acc[ai][bj][m][n] = __builtin_amdgcn_mfma_f32_16x16x32_bf16(Bt[n][k], At[m][k], acc[ai][bj][m][n], 0, 0, 0); __builtin_amdgcn_s_setprio(0); } while (0)
#define PG8_WAIT_V(n) asm volatile("s_waitcnt vmcnt(" #n ")" ::: "memory")
#define PG8_WAIT_L(n) asm volatile("s_waitcnt lgkmcnt(" #n ")" ::: "memory")
#define PG8_BAR __builtin_amdgcn_s_barrier()
#define PG8_SCHED __builtin_amdgcn_sched_barrier(0)
    Unit cur, nxt; int ui = 0;
    if (!S.next(0, cur)) return;
    f32x4 acc[2][2][4][2];
#pragma unroll
    for (int a = 0; a < 2; ++a)
#pragma unroll
        for (int b = 0; b < 2; ++b)
#pragma unroll
            for (int m = 0; m < 4; ++m)
#pragma unroll
                for (int n = 0; n < 2; ++n) acc[a][b][m][n] = (f32x4){0.f, 0.f, 0.f, 0.f};
    bf16x8 At[4][2], B0[2][2], B1[2][2];
    const char* cA = (const char*)g.A + (size_t)cur.pm * tstepA; const char* cB = (const char*)g.Bt + (size_t)cur.pn * tstepB;
    S.a_ready(cur);
    if constexpr (SP2) {
        PG8_STAGE(PG8_SB(0, 0), cB, voffB); PG8_STAGE(PG8_SB(0, 1), cB + hstepB, voffB); PG8_STAGE(PG8_SA(0, 0), cA, voffA); PG8_STAGE(PG8_SA(0, 1), cA + hstepA, voffA);
        if (wr == 1) PG8_BAR;
        PG8_WAIT_V(2); PG8_BAR;
        PG8_STAGE(PG8_SB(1, 0), cB + kstep, voffB); PG8_STAGE(PG8_SA(1, 0), cA + kstep, voffA); PG8_STAGE(PG8_SB(1, 1), cB + hstepB + kstep, voffB);
        PG8_WAIT_V(6); PG8_BAR;
    } else {
        PG8_STAGE(PG8_SB(0, 0), cB, voffB); PG8_STAGE(PG8_SA(0, 0), cA, voffA); PG8_STAGE(PG8_SB(0, 1), cB + hstepB, voffB); PG8_STAGE(PG8_SA(0, 1), cA + hstepA, voffA);
        if (wr == 1) PG8_BAR;
        PG8_WAIT_V(4); PG8_BAR;
        PG8_STAGE(PG8_SB(1, 0), cB + kstep, voffB); PG8_STAGE(PG8_SA(1, 0), cA + kstep, voffA); PG8_STAGE(PG8_SB(1, 1), cB + hstepB + kstep, voffB);
        PG8_WAIT_V(6); PG8_BAR;
    }
    for (;;) {
        const bool has_next = S.next(ui + 1, nxt);
        const char* nA = has_next ? (const char*)g.A + (size_t)nxt.pm * tstepA : cA; const char* nB = has_next ? (const char*)g.Bt + (size_t)nxt.pn * tstepB : cB;
        for (int t = 0; t < nt; t += 2) {
            if constexpr (Epi::MIDK) { if (t == (nt >> 1)) E.midk(acc, cur, wr, wc, fr, fq); }
            const bool last = (t == nt - 2);
            const char* a1 = cA + (size_t)(t + 1) * kstep;
            const char* a2 = last ? nA : cA + (size_t)(t + 2) * kstep; const char* b2 = last ? nB : cB + (size_t)(t + 2) * kstep;
            const char* a3 = a2 + kstep; const char* b3 = b2 + kstep;
            if (last && has_next) S.a_ready(nxt);
            if constexpr (SP2) {
            PG8_LDB(B0, 0, 0); PG8_LDB(B1, 0, 1); PG8_SCHED; PG8_LDA(At, 0, 0); PG8_STAGE(PG8_SA(1, 1), a1 + hstepA, voffA);
            PG8_WAIT_V(8); PG8_WAIT_L(0); PG8_BAR; PG8_MMA(0, 0, At, B0); PG8_MMA(0, 1, At, B1); PG8_BAR; PG8_SCHED;
            PG8_LDA(At, 0, 1); PG8_STAGE(PG8_SB(0, 0), b2, voffB); PG8_STAGE(PG8_SB(0, 1), b2 + hstepB, voffB); PG8_STAGE(PG8_SA(0, 0), a2, voffA);
            PG8_WAIT_V(8); PG8_WAIT_L(0); PG8_BAR; PG8_MMA(1, 0, At, B0); PG8_MMA(1, 1, At, B1); PG8_BAR; PG8_SCHED;
            PG8_LDB(B0, 1, 0); PG8_LDB(B1, 1, 1); PG8_SCHED; PG8_LDA(At, 1, 0); PG8_STAGE(PG8_SA(0, 1), a2 + hstepA, voffA);
            PG8_WAIT_V(8); PG8_WAIT_L(0); PG8_BAR; PG8_MMA(0, 0, At, B0); PG8_MMA(0, 1, At, B1); PG8_BAR; PG8_SCHED;
            PG8_LDA(At, 1, 1); PG8_STAGE(PG8_SB(1, 0), b3, voffB); PG8_STAGE(PG8_SB(1, 1), b3 + hstepB, voffB); PG8_STAGE(PG8_SA(1, 0), a3, voffA);
            PG8_WAIT_V(8); PG8_WAIT_L(0); PG8_BAR; PG8_MMA(1, 0, At, B0); PG8_MMA(1, 1, At, B1); PG8_BAR; PG8_SCHED;
            } else {
            PG8_LDB(B0, 0, 0); PG8_SCHED; PG8_LDA(At, 0, 0); PG8_STAGE(PG8_SA(1, 1), a1 + hstepA, voffA);
            PG8_WAIT_L(8); PG8_BAR; PG8_WAIT_L(0); PG8_MMA(0, 0, At, B0); PG8_BAR; PG8_SCHED;
            PG8_LDB(B1, 0, 1); PG8_STAGE(PG8_SB(0, 0), b2, voffB);
            PG8_BAR; PG8_WAIT_L(0); PG8_MMA(0, 1, At, B1); PG8_BAR;
            PG8_LDA(At, 0, 1); PG8_STAGE(PG8_SA(0, 0), a2, voffA);
            PG8_BAR; PG8_WAIT_L(0); PG8_MMA(1, 0, At, B0); PG8_BAR; PG8_SCHED;
            PG8_STAGE(PG8_SB(0, 1), b2 + hstepB, voffB);
            PG8_WAIT_V(6); PG8_BAR; PG8_MMA(1, 1, At, B1); PG8_BAR;
            PG8_LDB(B0, 1, 0); PG8_SCHED; PG8_LDA(At, 1, 0); PG8_STAGE(PG8_SA(0, 1), a2 + hstepA, voffA);
            PG8_WAIT_L(8); PG8_BAR; PG8_WAIT_L(0); PG8_MMA(0, 0, At, B0); PG8_BAR; PG8_SCHED;
            PG8_LDB(B1, 1, 1); PG8_STAGE(PG8_SB(1, 0), b3, voffB);
            PG8_BAR; PG8_WAIT_L(0); PG8_MMA(0, 1, At, B1); PG8_BAR;
            PG8_LDA(At, 1, 1); PG8_STAGE(PG8_SA(1, 0), a3, voffA);
            PG8_BAR; PG8_WAIT_L(0); PG8_MMA(1, 0, At, B0); PG8_BAR; PG8_SCHED;
            PG8_STAGE(PG8_SB(1, 1), b3 + hstepB, voffB);
            PG8_WAIT_V(6); PG8_BAR; PG8_MMA(1, 1, At, B1); PG8_BAR;
            }
        }
        if constexpr (ALIGN_EPI) { if (wr == 0) PG8_BAR; }
        if constexpr (!Epi::AFTER_DRAIN) { E(acc, cur, wr, wc, fr, fq); S.done(cur); }
        if (!has_next) break;
#pragma unroll
        for (int a = 0; a < 2; ++a)
#pragma unroll
            for (int b = 0; b < 2; ++b)
#pragma unroll
                for (int m = 0; m < 4; ++m)
#pragma unroll
                    for (int n = 0; n < 2; ++n) acc[a][b][m][n] = (f32x4){0.f, 0.f, 0.f, 0.f};
        cur = nxt; cA = nA; cB = nB; ++ui;
        if constexpr (ALIGN_EPI) { if (wr == 1) PG8_BAR; }
    }
    PG8_WAIT_V(0);
    if constexpr (!ALIGN_EPI) { if (wr == 0) PG8_BAR; }
    PG8_BAR;
    if constexpr (Epi::AFTER_DRAIN) { E.fused(acc, cur, wr, wc, fr, fq, lds, wid, lane); S.done(cur); }
#undef PG8_SA
#undef PG8_SB
#undef PG8_STAGE
#undef PG8_LDA
#undef PG8_LDB
#undef PG8_MMA
#undef PG8_WAIT_V
#undef PG8_WAIT_L
#undef PG8_BAR
#undef PG8_SCHED
}
}

constexpr int NTOK = 8192, SEQ = 4096, DM = 2048, DC = 1024, DS = 1024, NIN = 3072;
constexpr int NMEMTOK = 512  , HD = 512;
constexpr int PE = 16384;
constexpr float EPS = 1e-6f;
constexpr int NTHREADS = 512, NWAVES = 8;
constexpr int LDS_BYTES = 147456;

#define LAS __attribute__((address_space(3)))
typedef unsigned short bf16;
typedef float f32x4 __attribute__((ext_vector_type(4)));
typedef float f32x2 __attribute__((ext_vector_type(2)));
typedef short bf16x8 __attribute__((ext_vector_type(8)));
typedef unsigned u32x4 __attribute__((ext_vector_type(4)));
typedef unsigned u32x2 __attribute__((ext_vector_type(2)));

constexpr size_t MiB = 1u << 20;
constexpr size_t WS_CTL = 0;
constexpr size_t WS_WIN = 1 * MiB, WS_WKV = 13 * MiB, WS_WGLU = 29 * MiB, WS_WOUT = 31 * MiB, WS_WQ = 39 * MiB, WS_WO = 47 * MiB, WS_WPQ = 55 * MiB;
constexpr size_t WS_KEYS = 59 * MiB;
constexpr size_t WS_PART1 = 60 * MiB, WS_PART2 = 61 * MiB, WS_PARTS = 62 * MiB;
constexpr size_t WS_UB = 64 * MiB, WS_VB = 96 * MiB;
constexpr size_t WS_QSC = 63 * MiB;
constexpr size_t WS_AB = 192 * MiB;
constexpr size_t WS_PROJ = 224 * MiB;
constexpr size_t WS_MEMN = 272 * MiB, WS_KV = 274 * MiB;
constexpr size_t WS_G = 224 * MiB;
constexpr size_t WS_HC = 232 * MiB;
constexpr size_t WS_P = 240 * MiB;
constexpr size_t WS_Z = 278 * MiB;
constexpr size_t WS_YS = 294 * MiB;
constexpr size_t WS_Y = 310 * MiB;
constexpr size_t WS_H = 342 * MiB;
constexpr size_t WS_S5E = 406 * MiB, WS_S5F = 410 * MiB, WS_S5K = 414 * MiB, WS_S5L = 415 * MiB;
constexpr size_t WS_PU = 128 * MiB;
constexpr size_t WS_WP = 416 * MiB;
constexpr size_t WS_WSUM = 420 * MiB;
constexpr size_t WS_PARTF = 421 * MiB;
constexpr size_t WS_END = 422 * MiB;
constexpr int CW_CONVQ = 4096;

struct Args {
    const float* in[31];
    float* out;
    unsigned char* ws;
};

typedef __bf16 bf16x2_t __attribute__((ext_vector_type(2)));
__device__ __forceinline__ unsigned pk2(float lo, float hi) { const f32x2 v = {lo, hi}; return __builtin_bit_cast(unsigned, __builtin_convertvector(v, bf16x2_t)); }
__device__ __forceinline__ unsigned f2bf(float f) { return pk2(f, 0.0f) & 0xffffu; }
__device__ __forceinline__ float bflo(unsigned w) { return __builtin_bit_cast(float, w << 16); }
__device__ __forceinline__ float bfhi(unsigned w) { return __builtin_bit_cast(float, w & 0xffff0000u); }
__device__ __forceinline__ float bf2f(bf16 b) { return __builtin_bit_cast(float, (unsigned)b << 16); }
__device__ __forceinline__ float sigmoidf_(float x) { return __builtin_amdgcn_rcpf(1.0f + __expf(-x)); }
__device__ __forceinline__ float gelu_tanh(float x) { const float u = 1.5957691216057308f * (x + 0.044715f * x * x * x); return x * __builtin_amdgcn_rcpf(1.0f + __expf(-u)); }
__device__ __forceinline__ float wave_sum(float v) {
#pragma unroll
    for (int o = 1; o < 64; o <<= 1) v += __shfl_xor(v, o);
    return v;
}
__device__ __forceinline__ unsigned wave_umax(unsigned v) {
#pragma unroll
    for (int o = 1; o < 64; o <<= 1) { const unsigned t = (unsigned)__shfl_xor((int)v, o); v = t > v ? t : v; }
    return v;
}

template <int MODE, bool MIDK_ = false> struct Epi {
    static constexpr bool PERM = true, AFTER_DRAIN = false, MIDK = MIDK_;
    const float* mpart;
    LAS unsigned char* mlds;
    bf16* ob; int ldo; float cs;
    const float* rpart; int rnp;
    const bf16* zin;
    const float* hin; float* hout;
    float* wpart; int wnp;
    __device__ __forceinline__ void midk(pg8::f32x4 (&acc)[2][2][4][2], const pg8::Unit& u, int wr, int wc, int fr, int fq) const {
        const LAS float* rt = (const LAS float*)mlds;
#pragma unroll
        for (int ai = 0; ai < 2; ++ai)
#pragma unroll
            for (int m = 0; m < 4; ++m) {
                const float r = rt[ai * 128 + wr * 64 + m * 16 + fr];
#pragma unroll
                for (int bj = 0; bj < 2; ++bj) { acc[ai][bj][m][0] = acc[ai][bj][m][0] * r; acc[ai][bj][m][1] = acc[ai][bj][m][1] * r; }
            }
    }
    __device__ __forceinline__ void operator()(const pg8::f32x4 (&acc)[2][2][4][2], const pg8::Unit& u, int wr, int wc, int fr, int fq) const {
#pragma unroll
        for (int ai = 0; ai < 2; ++ai)
#pragma unroll
            for (int m = 0; m < 4; ++m) {
                const int row = u.pm * 256 + ai * 128 + wr * 64 + m * 16 + fr;
                float sc = cs;
                if (MODE == 0 && rpart) {
                    float s = 0.f;
                    for (int i = 0; i < rnp; i += 4) { const f32x4 v = *(const f32x4*)(rpart + (size_t)row * rnp + i); s += (v[0] + v[1]) + (v[2] + v[3]); }
                    sc *= __builtin_amdgcn_rsqf(s * (1.0f / 2048.0f) + EPS);
                }
                float ss = 0.f;
#pragma unroll
                for (int bj = 0; bj < 2; ++bj) {
                    const int col0 = u.pn * 256 + bj * 128 + wc * 32 + 8 * fq;
                    f32x4 v0 = acc[ai][bj][m][0], v1 = acc[ai][bj][m][1];
                    if (MODE == 0) { v0 = v0 * sc; v1 = v1 * sc; }
                    if (MODE == 1) {
                        const u32x4 zw = *(const u32x4*)(zin + (size_t)row * 1024 + col0);
                        v0[0] = bflo(zw[0]) * sigmoidf_(v0[0]); v0[1] = bfhi(zw[0]) * sigmoidf_(v0[1]); v0[2] = bflo(zw[1]) * sigmoidf_(v0[2]); v0[3] = bfhi(zw[1]) * sigmoidf_(v0[3]);
                        v1[0] = bflo(zw[2]) * sigmoidf_(v1[0]); v1[1] = bfhi(zw[2]) * sigmoidf_(v1[1]); v1[2] = bflo(zw[3]) * sigmoidf_(v1[2]); v1[3] = bfhi(zw[3]) * sigmoidf_(v1[3]);
                    }
                    if (MODE == 2) {
                        if (hin) {
                            const f32x4 h0 = *(const f32x4*)(hin + (size_t)row * 2048 + col0), h1 = *(const f32x4*)(hin + (size_t)row * 2048 + col0 + 4);
                            v0 = v0 + h0; v1 = v1 + h1;
                        } else {
                            const u32x4 hw = *(const u32x4*)(zin + (size_t)row * 2048 + col0);
                            v0[0] += bflo(hw[0]); v0[1] += bfhi(hw[0]); v0[2] += bflo(hw[1]); v0[3] += bfhi(hw[1]);
                            v1[0] += bflo(hw[2]); v1[1] += bfhi(hw[2]); v1[2] += bflo(hw[3]); v1[3] += bfhi(hw[3]);
                        }
                    }
                    if (MODE != 0) ss += (v0[0] * v0[0] + v0[1] * v0[1]) + (v0[2] * v0[2] + v0[3] * v0[3]) + (v1[0] * v1[0] + v1[1] * v1[1]) + (v1[2] * v1[2] + v1[3] * v1[3]);
                    u32x4 w; w[0] = pk2(v0[0], v0[1]); w[1] = pk2(v0[2], v0[3]); w[2] = pk2(v1[0], v1[1]); w[3] = pk2(v1[2], v1[3]);
                    *(u32x4*)(ob + (size_t)row * ldo + col0) = w;
                }
                if (MODE != 0) {
                    ss += __shfl_xor(ss, 16); ss += __shfl_xor(ss, 32);
                    if (fq == 0) wpart[(size_t)row * wnp + u.pn * 4 + wc] = ss;
                }
            }
    }
};

struct EpiSoftmax {
    static constexpr bool PERM = true, AFTER_DRAIN = true, MIDK = false;
    bf16* P; int ldp; const float* rpart; float cs;
    __device__ __forceinline__ void fused(pg8::f32x4 (&acc)[2][2][4][2], const pg8::Unit& u, int wr, int wc, int fr, int fq, LAS unsigned char* lds, int wid, int lane) const {
        LAS float* exm = (LAS float*)lds;
        LAS float* exs = exm + 1024;
        float mloc[2][4];
#pragma unroll
        for (int ai = 0; ai < 2; ++ai)
#pragma unroll
            for (int m = 0; m < 4; ++m) {
                const int rl = ai * 128 + wr * 64 + m * 16 + fr, row = u.pm * 256 + rl;
                float s = 0.f;
#pragma unroll
                for (int i = 0; i < 32; i += 4) { const f32x4 v = *(const f32x4*)(rpart + (size_t)row * 32 + i); s += (v[0] + v[1]) + (v[2] + v[3]); }
                const float sc = cs * __builtin_amdgcn_rsqf(s * (1.0f / 2048.0f) + EPS);
                float mx = -3.0e38f;
#pragma unroll
                for (int bj = 0; bj < 2; ++bj)
#pragma unroll
                    for (int n = 0; n < 2; ++n) { acc[ai][bj][m][n] = acc[ai][bj][m][n] * sc; const f32x4 v = acc[ai][bj][m][n]; mx = fmaxf(mx, fmaxf(fmaxf(v[0], v[1]), fmaxf(v[2], v[3]))); }
                mx = fmaxf(mx, __shfl_xor(mx, 16)); mx = fmaxf(mx, __shfl_xor(mx, 32));
                if (fq == 0) exm[rl * 4 + wc] = mx;
            }
        __syncthreads();
#pragma unroll
        for (int ai = 0; ai < 2; ++ai)
#pragma unroll
            for (int m = 0; m < 4; ++m) {
                const int rl = ai * 128 + wr * 64 + m * 16 + fr;
                const f32x4 mv = *(const LAS f32x4*)(exm + rl * 4);
                const float mx = fmaxf(fmaxf(mv[0], mv[1]), fmaxf(mv[2], mv[3]));
                float sm = 0.f;
#pragma unroll
                for (int bj = 0; bj < 2; ++bj)
#pragma unroll
                    for (int n = 0; n < 2; ++n) {
                        f32x4 v = acc[ai][bj][m][n];
                        v[0] = __expf(v[0] - mx); v[1] = __expf(v[1] - mx); v[2] = __expf(v[2] - mx); v[3] = __expf(v[3] - mx);
                        acc[ai][bj][m][n] = v; sm += (v[0] + v[1]) + (v[2] + v[3]);
                    }
                sm += __shfl_xor(sm, 16); sm += __shfl_xor(sm, 32);
                if (fq == 0) exs[rl * 4 + wc] = sm;
                mloc[ai][m] = 0.f;
            }
        __syncthreads();
#pragma unroll
        for (int ai = 0; ai < 2; ++ai)
#pragma unroll
            for (int m = 0; m < 4; ++m) {
                const int rl = ai * 128 + wr * 64 + m * 16 + fr;
                const f32x4 sv = *(const LAS f32x4*)(exs + rl * 4);
                const float inv = __builtin_amdgcn_rcpf((sv[0] + sv[1]) + (sv[2] + sv[3]));
#pragma unroll
                for (int bj = 0; bj < 2; ++bj) {
                    const f32x4 v0 = acc[ai][bj][m][0] * inv, v1 = acc[ai][bj][m][1] * inv;
                    u32x4 w; w[0] = pk2(v0[0], v0[1]); w[1] = pk2(v0[2], v0[3]); w[2] = pk2(v1[0], v1[1]); w[3] = pk2(v1[2], v1[3]);
                    *(u32x4*)(P + (size_t)(u.pm * 256 + rl) * ldp + u.pn * 256 + bj * 128 + wc * 32 + 8 * fq) = w;
                }
            }
        (void)mloc; (void)wid; (void)lane;
        __syncthreads();
    }
};

template <class EPI, bool ALIGN = true> __device__ __forceinline__ void run_gemm(LAS unsigned char* lds, const bf16* A, const bf16* Bt, int M_, int N_, int K_, const EPI& E, int cshift = 0, int lda = 0, int ldb = 0) {
    pg8::Gemm g{A, Bt, M_, N_, K_, lda ? lda : K_, ldb ? ldb : K_}; pg8::StaticOrder S; S.init(M_, N_, (int)gridDim.x, (int)((blockIdx.x + gridDim.x - cshift) % gridDim.x));
    pg8::gemm_phase<EPI, pg8::StaticOrder, ALIGN, true>(lds, g, S, E);
}

__device__ __forceinline__ void quant_rows(const Args& a, int r0, int r1) {
    int tid_ = threadIdx.x; asm volatile("" : "+v"(tid_));
    const int tid = tid_, lane = tid & 63, wave = tid >> 6;
    unsigned char* ws = a.ws;
    const float* gf = a.in[25];
    unsigned char* Uq = ws + WS_UB; unsigned char* Vq = ws + WS_VB;
    float* su = (float*)(ws + WS_QSC); float* sv = su + PE;
#define QR_LOAD(v, r) do { const float* src_ = (((r) < PE) ? a.in[28] + (size_t)(r) * 2048 : a.in[29] + (size_t)((r) - PE) * 2048); \
        _Pragma("unroll") for (int j_ = 0; j_ < 8; ++j_) v[j_] = __builtin_nontemporal_load((const f32x4*)(src_ + 4 * (lane + 64 * j_))); } while (0)
#define QR_PROC(v, r) do { const bool isu_ = (r) < PE; const int e_ = isu_ ? (r) : (r) - PE; float mx_ = 0.f; \
        _Pragma("unroll") for (int j_ = 0; j_ < 8; ++j_) { if (isu_) v[j_] = v[j_] * *(const f32x4*)(gf + 4 * (lane + 64 * j_)); \
            mx_ = fmaxf(mx_, fmaxf(fmaxf(fabsf(v[j_][0]), fabsf(v[j_][1])), fmaxf(fabsf(v[j_][2]), fabsf(v[j_][3])))); } \
        _Pragma("unroll") for (int o_ = 1; o_ < 64; o_ <<= 1) mx_ = fmaxf(mx_, __shfl_xor(mx_, o_)); \
        mx_ = fmaxf(mx_, 1e-30f); const float inv_ = 127.0f * __builtin_amdgcn_rcpf(mx_); unsigned char* tab_ = isu_ ? Uq : Vq; \
        _Pragma("unroll") for (int j_ = 0; j_ < 8; ++j_) { unsigned w_ = 0u; \
            _Pragma("unroll") for (int k_ = 0; k_ < 4; ++k_) { const int q_ = (int)rintf(v[j_][k_] * inv_); w_ |= ((unsigned)q_ & 0xffu) << (8 * k_); } \
            __builtin_nontemporal_store(w_, (unsigned*)(tab_ + ((size_t)(2 * j_ + (lane >> 5)) * PE + e_) * 128 + 4 * (lane & 31))); } \
        if (lane == 0) (isu_ ? su : sv)[e_] = mx_ * (1.0f / 127.0f); } while (0)
    f32x4 va[8], vb[8];
    int r = r0 + wave;
    if (r < r1) QR_LOAD(va, r);
    for (; r < r1; r += 2 * NWAVES) {
        const int rn = r + NWAVES;
        if (rn < r1) QR_LOAD(vb, rn);
        QR_PROC(va, r);
        if (rn < r1) {
            if (rn + NWAVES < r1) QR_LOAD(va, rn + NWAVES);
            QR_PROC(vb, rn);
        }
    }
#undef QR_LOAD
#undef QR_PROC
}

__device__ __forceinline__ void p0_transpose_item(const float* W, int K, int N, bf16* WT, const float* sc0, const float* sc1, int ksplit, LAS float* scr, int item, int lane, int krot = 0) {
    const int nblk = N / 32, kb = item / nblk, nb = item % nblk, k0 = 64 * kb, n0 = 32 * nb;
    f32x4 v[8];
#pragma unroll
    for (int i = 0; i < 8; ++i) {
        const int kk = 8 * i + (lane >> 3), k = (k0 + kk + krot) & (K - 1);
        v[i] = __builtin_nontemporal_load((const f32x4*)(W + (size_t)k * N + n0 + 4 * (lane & 7)));
        if (sc0) v[i] = v[i] * ((k < ksplit) ? sc0[k] : sc1[k - ksplit]);
    }
#pragma unroll
    for (int i = 0; i < 8; ++i) {
        const int kk = 8 * i + (lane >> 3); LAS float* d = scr + kk * 33 + 4 * (lane & 7);
        d[0] = v[i][0]; d[1] = v[i][1]; d[2] = v[i][2]; d[3] = v[i][3];
    }
    asm volatile("s_waitcnt lgkmcnt(0)" ::: "memory");
    const int c = lane & 7;
#pragma unroll
    for (int j = 0; j < 4; ++j) {
        const int n = (lane >> 3) + 8 * j; const LAS float* s = scr + (8 * c) * 33 + n;
        u32x4 o; o[0] = pk2(s[0 * 33], s[1 * 33]); o[1] = pk2(s[2 * 33], s[3 * 33]); o[2] = pk2(s[4 * 33], s[5 * 33]); o[3] = pk2(s[6 * 33], s[7 * 33]);
        *(u32x4*)(WT + (size_t)(n0 + n) * K + k0 + 8 * c) = o;
    }
    asm volatile("s_waitcnt lgkmcnt(0)" ::: "memory");
}
#define RR_LOAD(v, m) do { const float* x_ = ((m) < NTOK) ? a.in[0] + (size_t)(m) * 2048 : a.in[1] + (size_t)((m) - NTOK) * 2048; \
        _Pragma("unroll") for (int j_ = 0; j_ < 8; ++j_) v[j_] = __builtin_nontemporal_load((const f32x4*)(x_ + 4 * (lane + 64 * j_))); } while (0)
#define RR_PROC(v, m) do { const float* gain_ = ((m) < NTOK) ? a.in[2] : a.in[21]; \
        bf16* o_ = ((m) < NTOK) ? (bf16*)(a.ws + WS_AB) + (size_t)(m) * 2048 : (bf16*)(a.ws + WS_MEMN) + (size_t)((m) - NTOK) * 2048; float s_ = 0.f; \
        _Pragma("unroll") for (int j_ = 0; j_ < 8; ++j_) s_ += (v[j_][0] * v[j_][0] + v[j_][1] * v[j_][1]) + (v[j_][2] * v[j_][2] + v[j_][3] * v[j_][3]); \
        const float rinv_ = __builtin_amdgcn_rsqf(wave_sum(s_) * (1.0f / 2048.0f) + EPS); \
        _Pragma("unroll") for (int j_ = 0; j_ < 8; ++j_) { const f32x4 g_ = *(const f32x4*)(gain_ + 4 * (lane + 64 * j_)); \
            u32x2 w_; w_[0] = pk2(v[j_][0] * rinv_ * g_[0], v[j_][1] * rinv_ * g_[1]); w_[1] = pk2(v[j_][2] * rinv_ * g_[2], v[j_][3] * rinv_ * g_[3]); \
            *(u32x2*)(o_ + 4 * (lane + 64 * j_)) = w_; } } while (0)
__device__ __forceinline__ void rms_rows_to_bf16(const Args& a, int m0, int step, int m1, int lane) {
    f32x4 va[8], vb[8];
    int m = m0;
    if (m < m1) RR_LOAD(va, m);
    for (; m < m1; m += 2 * step) {
        const int mn = m + step;
        if (mn < m1) RR_LOAD(vb, mn);
        RR_PROC(va, m);
        if (mn < m1) {
            if (mn + step < m1) RR_LOAD(va, mn + step);
            RR_PROC(vb, mn);
        }
    }
}
__device__ __forceinline__ void s5_tables(const Args& a, LAS unsigned char* lds, int g, int part);
__device__ __forceinline__ void ph_prologue(const Args& a, LAS unsigned char* lds) {
    int tid_ = threadIdx.x; asm volatile("" : "+v"(tid_));
    const int tid = tid_, lane = tid & 63, wave = tid >> 6;
    const int gw = blockIdx.x * NWAVES + wave, NGW = gridDim.x * NWAVES;
    LAS float* scr = (LAS float*)(lds + wave * 16384);
    unsigned char* ws = a.ws;
    for (int j = blockIdx.x; j < 256; j += gridDim.x) s5_tables(a, lds, j >> 2, j & 3);
    constexpr int I_IN = 32 * 96, I_KV = 32 * 128, I_GLU = 16 * 32, I_OUT = 32 * 64, I_O = 32 * 64, I_PQ = 32 * 32;
    constexpr int NIT = I_IN + I_KV + I_GLU + I_OUT + I_O + I_PQ;
    for (int it = gw; it < NIT; it += NGW) {
        int r = it;
        if (r < I_IN) { p0_transpose_item(a.in[3], 2048, 3072, (bf16*)(ws + WS_WIN), nullptr, nullptr, 0, scr, r, lane); continue; } r -= I_IN;
        if (r < I_KV) { p0_transpose_item(a.in[23], 2048, 4096, (bf16*)(ws + WS_WKV), nullptr, nullptr, 0, scr, r, lane); continue; } r -= I_KV;
        if (r < I_GLU) { p0_transpose_item(a.in[16], 1024, 1024, (bf16*)(ws + WS_WGLU), nullptr, nullptr, 0, scr, r, lane); continue; } r -= I_GLU;
        if (r < I_OUT) { p0_transpose_item(a.in[19], 2048, 2048, (bf16*)(ws + WS_WOUT), a.in[17], a.in[18], 1024, scr, r, lane, 1024); continue; } r -= I_OUT;
        if (r < I_O) { p0_transpose_item(a.in[24], 2048, 2048, (bf16*)(ws + WS_WO), nullptr, nullptr, 0, scr, r, lane); continue; } r -= I_O;
        p0_transpose_item(a.in[26], 2048, 1024, (bf16*)(ws + WS_WPQ), a.in[25], a.in[25], 2048, scr, r, lane);
    }
    rms_rows_to_bf16(a, gw, NGW, NTOK + NMEMTOK, lane);
    const size_t gt = (size_t)blockIdx.x * NTHREADS + tid, NGT = (size_t)gridDim.x * NTHREADS;
    for (size_t i = gt; i < (size_t)2048 * 2048 / 8; i += NGT) {
        const float gk = a.in[20][(i * 8) >> 11];
        const f32x4 w0 = __builtin_nontemporal_load((const f32x4*)(a.in[22] + i * 8)), w1 = __builtin_nontemporal_load((const f32x4*)(a.in[22] + i * 8 + 4));
        u32x4 o; o[0] = pk2(w0[0] * gk, w0[1] * gk); o[1] = pk2(w0[2] * gk, w0[3] * gk); o[2] = pk2(w1[0] * gk, w1[1] * gk); o[3] = pk2(w1[2] * gk, w1[3] * gk);
        *(u32x4*)((bf16*)(ws + WS_WQ) + i * 8) = o;
    }
    for (size_t i = gt; i < (size_t)(16 * 128 * 64) / 8; i += NGT) {
        const f32x4 k0 = *(const f32x4*)(a.in[27] + i * 8), k1 = *(const f32x4*)(a.in[27] + i * 8 + 4);
        u32x4 o; o[0] = pk2(k0[0], k0[1]); o[1] = pk2(k0[2], k0[3]); o[2] = pk2(k1[0], k1[1]); o[3] = pk2(k1[2], k1[3]);
        *(u32x4*)((bf16*)(ws + WS_KEYS) + i * 8) = o;
    }
}

__device__ __forceinline__ float wave_sum_dpp(float v) {
    v += __builtin_bit_cast(float, __builtin_amdgcn_update_dpp(0, __builtin_bit_cast(int, v), 0xB1, 0xf, 0xf, false));
    v += __builtin_bit_cast(float, __builtin_amdgcn_update_dpp(0, __builtin_bit_cast(int, v), 0x4E, 0xf, 0xf, false));
    v += __builtin_bit_cast(float, __builtin_amdgcn_update_dpp(0, __builtin_bit_cast(int, v), 0x141, 0xf, 0xf, false));
    v += __builtin_bit_cast(float, __builtin_amdgcn_update_dpp(0, __builtin_bit_cast(int, v), 0x140, 0xf, 0xf, false));
    const int vi = __builtin_bit_cast(int, v);
    return (__builtin_bit_cast(float, __builtin_amdgcn_readlane(vi, 0)) + __builtin_bit_cast(float, __builtin_amdgcn_readlane(vi, 16))) +
           (__builtin_bit_cast(float, __builtin_amdgcn_readlane(vi, 32)) + __builtin_bit_cast(float, __builtin_amdgcn_readlane(vi, 48)));
}
struct ConvState { f32x2 w[31], acc[31]; unsigned pa[16], pg[16]; f32x2 b; f32x4 gg[4], bb[4]; };
__device__ __forceinline__ void conv_norm_row(const LAS float* co, const f32x4 (&gg)[4], const f32x4 (&bb)[4], bf16* yr, int wave, int lane) {
    f32x4 v[4]; float s = 0.f;
#pragma unroll
    for (int i = 0; i < 4; ++i) { v[i] = *(const LAS f32x4*)(co + wave * 1024 + 4 * (lane + 64 * i)); s += (v[i][0] + v[i][1]) + (v[i][2] + v[i][3]); }
    const float mean = wave_sum_dpp(s) * (1.0f / 1024.0f); float q = 0.f;
#pragma unroll
    for (int i = 0; i < 4; ++i) { v[i] = v[i] - mean; q += (v[i][0] * v[i][0] + v[i][1] * v[i][1]) + (v[i][2] * v[i][2] + v[i][3] * v[i][3]); }
    const float rstd = __builtin_amdgcn_rsqf(wave_sum_dpp(q) * (1.0f / 1024.0f) + EPS); float ss = 0.f;
#pragma unroll
    for (int i = 0; i < 4; ++i) {
#pragma unroll
        for (int e = 0; e < 4; ++e) { const float y = v[i][e] * rstd * gg[i][e] + bb[i][e]; const float sw = y * sigmoidf_(y); v[i][e] = sw; ss += sw * sw; }
    }
    const float rinv = __builtin_amdgcn_rsqf(wave_sum_dpp(ss) * (1.0f / 1024.0f) + EPS);
#pragma unroll
    for (int i = 0; i < 4; ++i) { u32x2 o; o[0] = pk2(v[i][0] * rinv, v[i][1] * rinv); o[1] = pk2(v[i][2] * rinv, v[i][3] * rinv); *(u32x2*)(yr + 4 * (lane + 64 * i)) = o; }
}
constexpr int CONV_T = 64, CONV_STEPS = CONV_T + 30, CONV_RING = 16;
template <int TAU> struct ConvStep {
    static __device__ __forceinline__ void run(ConvState& S, const bf16* pbase, int tl0, LAS float* co, bf16* Y, int t0, int tid, int wave, int lane) {
        if constexpr ((TAU & 3) == 0) __builtin_amdgcn_sched_barrier(0);
        const unsigned av = S.pa[TAU % CONV_RING], gv = S.pg[TAU % CONV_RING];
        if constexpr (TAU + CONV_RING < CONV_STEPS) {
            if constexpr (TAU + CONV_RING < 30) {
                const int tl = tl0 - 30 + TAU + CONV_RING, tlc = tl < 0 ? 0 : tl;
                const unsigned va = *(const unsigned*)(pbase + (size_t)tlc * NIN), vg = *(const unsigned*)(pbase + (size_t)tlc * NIN + 1024);
                S.pa[TAU % CONV_RING] = tl < 0 ? 0u : va; S.pg[TAU % CONV_RING] = vg;
            } else {
                const bf16* pp = pbase + (size_t)(tl0 + (TAU + CONV_RING - 30)) * NIN;
                S.pa[TAU % CONV_RING] = *(const unsigned*)pp; S.pg[TAU % CONV_RING] = *(const unsigned*)(pp + 1024);
            }
        }
        const f32x2 x = (f32x2){bflo(av) * sigmoidf_(bflo(gv)), bfhi(av) * sigmoidf_(bfhi(gv))};
#pragma unroll
        for (int j = 0; j < 31; ++j) S.acc[(TAU + j) % 31] = __builtin_elementwise_fma(S.w[30 - j], x, S.acc[(TAU + j) % 31]);
        constexpr int sl = TAU % 31;
        if constexpr (TAU >= 30) {
            constexpr int row = (TAU - 30) & 7, buf = ((TAU - 30) >> 3) & 1;
            *(LAS f32x2*)(co + buf * 8192 + row * 1024 + 2 * tid) = S.acc[sl];
            if constexpr (row == 7) {
                __syncthreads();
                conv_norm_row(co + buf * 8192, S.gg, S.bb, Y + (size_t)(t0 + (TAU - 37) + wave) * 2048 + 1024, wave, lane);
            }
        }
        S.acc[sl] = S.b;
        ConvStep<TAU + 1>::run(S, pbase, tl0, co, Y, t0, tid, wave, lane);
    }
};
template <> struct ConvStep<CONV_STEPS> {
    static __device__ __forceinline__ void run(ConvState&, const bf16*, int, LAS float*, bf16*, int, int, int, int) {}
};
__device__ __forceinline__ void ph_conv(const Args& a, LAS unsigned char* lds) {
    int tid_ = threadIdx.x; asm volatile("" : "+v"(tid_));
    const int tid = tid_, lane = tid & 63, wave = tid >> 6;
    const bf16* proj = (const bf16*)(a.ws + WS_PROJ);
    bf16* Y = (bf16*)(a.ws + WS_Y);
    LAS float* co = (LAS float*)lds;
    const float* cw = a.in[4]; const float* cb = a.in[5]; const float* lng = a.in[6]; const float* lnb = a.in[7];
    if (blockIdx.x < 128) return;
    ConvState S;
#pragma unroll
    for (int k = 0; k < 31; ++k) S.w[k] = *(const f32x2*)(cw + k * 1024 + 2 * tid);
    S.b = *(const f32x2*)(cb + 2 * tid);
#pragma unroll
    for (int i = 0; i < 4; ++i) { S.gg[i] = *(const f32x4*)(lng + 4 * (lane + 64 * i)); S.bb[i] = *(const f32x4*)(lnb + 4 * (lane + 64 * i)); }
    for (int item = (int)blockIdx.x - 128; item < NTOK / CONV_T; item += 128) {
        const int t0 = item * CONV_T, b = t0 / SEQ, tl0 = t0 % SEQ;
        const bf16* pbase = proj + (size_t)(b * SEQ) * NIN + 2 * tid;
#pragma unroll
        for (int s = 0; s < 31; ++s) S.acc[s] = S.b;
#pragma unroll
        for (int d = 0; d < CONV_RING; ++d) {
            const int tl = tl0 - 30 + d, tlc = tl < 0 ? 0 : tl;
            const unsigned va = *(const unsigned*)(pbase + (size_t)tlc * NIN), vg = *(const unsigned*)(pbase + (size_t)tlc * NIN + 1024);
            S.pa[d] = tl < 0 ? 0u : va; S.pg[d] = vg;
        }
        ConvStep<0>::run(S, pbase, tl0, co, Y, t0, tid, wave, lane);
        __syncthreads();
    }
}

__device__ __forceinline__ void s5_tables(const Args& a, LAS unsigned char* lds, int g, int part) {
    int tid_ = threadIdx.x; asm volatile("" : "+v"(tid_));
    const int tid = tid_;
    LAS float* pwr = (LAS float*)lds;
    LAS float* pwi = pwr + 17 * 64;
    LAS float* bbr = pwi + 17 * 64;
    LAS float* bbi = bbr + 1024;
    LAS float* cr = bbi + 1024;
    LAS float* ci = cr + 1024;
    const float dt = __expf(a.in[10][g]);
    for (int e = tid; e < 17 * 64; e += NTHREADS) {
        const int n = e >> 6, p = e & 63;
        const float lre = a.in[8][g * 64 + p], lim = a.in[9][g * 64 + p];
        const float er = expf((float)n * lre * dt); float sn, cs; sincosf((float)n * lim * dt, &sn, &cs); pwr[e] = er * cs; pwi[e] = er * sn;
    }
    for (int e = tid; e < 1024; e += NTHREADS) {
        const int p = e >> 4, h = e & 15;
        const float lre = a.in[8][g * 64 + p], lim = a.in[9][g * 64 + p];
        const float er = expf(lre * dt); float sn, cs; sincosf(lim * dt, &sn, &cs);
        const float x = er * cs - 1.0f, y = er * sn, den = 1.0f / (lre * lre + lim * lim);
        const float fr = (x * lre + y * lim) * den, fi = (y * lre - x * lim) * den;
        const float br = a.in[11][((size_t)g * 64 + p) * 16 + h], bi = a.in[12][((size_t)g * 64 + p) * 16 + h];
        bbr[e] = fr * br - fi * bi; bbi[e] = fr * bi + fi * br;
        cr[e] = a.in[13][(size_t)g * 1024 + e]; ci[e] = a.in[14][(size_t)g * 1024 + e];
    }
    __syncthreads();
    bf16* E = (bf16*)(a.ws + WS_S5E) + (size_t)g * 32768;
    bf16* F = (bf16*)(a.ws + WS_S5F) + (size_t)g * 32768;
    bf16* K16 = (bf16*)(a.ws + WS_S5K) + (size_t)g * 4096;
    float* L16 = (float*)(a.ws + WS_S5L) + (size_t)g * 128;
    for (int e2 = part * 4096 + tid; e2 < part * 4096 + 4096; e2 += NTHREADS) {
        const int row = e2 >> 7, col = (e2 & 127) * 2, c2 = row >> 6, p = row & 63, j = col >> 4, h0 = col & 15;
        const float pr = pwr[(15 - j) * 64 + p], pi = pwi[(15 - j) * 64 + p];
        float v[2];
#pragma unroll
        for (int t = 0; t < 2; ++t) { const float br = bbr[p * 16 + h0 + t], bi = bbi[p * 16 + h0 + t]; v[t] = c2 ? (pr * bi + pi * br) : (pr * br - pi * bi); }
        *(unsigned*)(E + (size_t)row * 256 + col) = pk2(v[0], v[1]);
    }
    for (int e2 = part * 4096 + tid; e2 < part * 4096 + 4096; e2 += NTHREADS) {
        const int row = e2 >> 6, col = (e2 & 63) * 2, r = row >> 4, h = row & 15, c2 = col >> 6, p0 = col & 63;
        float v[2];
#pragma unroll
        for (int t = 0; t < 2; ++t) {
            const int p = p0 + t; const float pr = pwr[(r + 1) * 64 + p], pi = pwi[(r + 1) * 64 + p], xr = cr[h * 64 + p], xi = ci[h * 64 + p];
            v[t] = c2 ? -(xr * pi + xi * pr) : (xr * pr - xi * pi);
        }
        *(unsigned*)(F + (size_t)row * 128 + col) = pk2(v[0], v[1]);
    }
    {
        const int e2 = part * 512 + tid;
        const int tau = e2 >> 7, h = (e2 >> 3) & 15, hp0 = (e2 & 7) * 2;
        float s0 = 0.f, s1 = 0.f;
        for (int p = 0; p < 64; ++p) {
            const float pr = pwr[tau * 64 + p], pi = pwi[tau * 64 + p], xr = cr[h * 64 + p], xi = ci[h * 64 + p];
            const float wr = xr * pr - xi * pi, wi = xr * pi + xi * pr;
            s0 += wr * bbr[p * 16 + hp0] - wi * bbi[p * 16 + hp0]; s1 += wr * bbr[p * 16 + hp0 + 1] - wi * bbi[p * 16 + hp0 + 1];
        }
        *(unsigned*)(K16 + (size_t)(tau * 16 + h) * 16 + hp0) = pk2(s0, s1);
    }
    if (part == 0 && tid < 64) { L16[tid] = pwr[16 * 64 + tid]; L16[64 + tid] = pwi[16 * 64 + tid]; }
    __syncthreads();
}

__device__ __forceinline__ void ph_s5(const Args& a, LAS unsigned char* lds) {
    int tid_ = threadIdx.x; asm volatile("" : "+v"(tid_));
    const int tid = tid_, lane = tid & 63, wave = __builtin_amdgcn_readfirstlane(tid >> 6), l15 = lane & 15, s4 = lane >> 4;
    const bf16* proj = (const bf16*)(a.ws + WS_PROJ);
    bf16* Z = (bf16*)(a.ws + WS_Z);
    LAS float* lbuf = (LAS float*)(lds + 2 * 33792);
    LAS unsigned char* sb = lds + 2 * 33792 + 33280;
    for (int prob = blockIdx.x; prob < 128; prob += gridDim.x) {
        const int b = prob >> 6, g = prob & 63;
        const bf16* E = (const bf16*)(a.ws + WS_S5E) + (size_t)g * 32768;
        const bf16* F = (const bf16*)(a.ws + WS_S5F) + (size_t)g * 32768;
        const bf16* K16 = (const bf16*)(a.ws + WS_S5K) + (size_t)g * 4096;
        const float* L16 = (const float*)(a.ws + WS_S5L) + (size_t)g * 128;
        const float l16r = L16[lane], l16i = L16[64 + lane];
        float m16r = l16r, m16i = l16i;
#pragma unroll
        for (int q = 0; q < 4; ++q) { const float nr = m16r * m16r - m16i * m16i, ni = 2.0f * m16r * m16i; m16r = nr; m16i = ni; }
        const f32x4 dco = *(const f32x4*)(a.in[15] + g * 16 + 4 * s4);
        bf16x8 ef[8], ff[2][4], kf[2][8];
#pragma unroll
        for (int ks = 0; ks < 8; ++ks) ef[ks] = *(const bf16x8*)(E + (size_t)(16 * wave + l15) * 256 + 8 * s4 + 32 * ks);
#pragma unroll
        for (int rr = 0; rr < 2; ++rr) {
            const int r = wave + 8 * rr;
#pragma unroll
            for (int ks = 0; ks < 4; ++ks) ff[rr][ks] = *(const bf16x8*)(F + (size_t)(16 * r + l15) * 128 + 8 * s4 + 32 * ks);
#pragma unroll
            for (int q = 0; q < 8; ++q) if (rr == 1 || q < 4) {
                const int tau = r - (2 * q + (s4 >> 1)), tc = tau < 0 ? 0 : tau;
                const u32x4 kw = *(const u32x4*)(K16 + (size_t)(tc * 16 + l15) * 16 + 8 * (s4 & 1));
                kf[rr][q] = __builtin_bit_cast(bf16x8, tau < 0 ? (u32x4){0u, 0u, 0u, 0u} : kw);
            }
        }
        float Sr = 0.f, Si = 0.f;
        {
            const size_t segtok0 = (size_t)b * SEQ;
#pragma unroll
            for (int i = 0; i < 2; ++i) {
                const int t2 = tid + i * NTHREADS;
                const bf16* src = proj + (segtok0 + t2) * NIN + 2048 + g * 16;
                const u32x4 v0 = *(const u32x4*)src, v1 = *(const u32x4*)(src + 8);
                LAS unsigned char* dst = lds + (t2 >> 4) * 528 + (t2 & 15) * 32;
                *(LAS u32x4*)dst = v0; *(LAS u32x4*)(dst + 16) = v1;
            }
        }
        __syncthreads();
        for (int seg = 0; seg < 4; ++seg) {
            const size_t segtok0 = (size_t)b * SEQ + seg * 1024;
            LAS unsigned char* useg = lds + (seg & 1) * 33792;
            LAS unsigned char* unext = lds + ((seg + 1) & 1) * 33792;
            u32x4 pf[4];
            if (seg < 3) {
#pragma unroll
                for (int i = 0; i < 2; ++i) {
                    const int t2 = tid + i * NTHREADS;
                    const bf16* src = proj + (segtok0 + 1024 + t2) * NIN + 2048 + g * 16;
                    pf[2 * i] = *(const u32x4*)src; pf[2 * i + 1] = *(const u32x4*)(src + 8);
                }
            }
            {
                f32x4 acc[4];
#pragma unroll
                for (int nb = 0; nb < 4; ++nb) acc[nb] = (f32x4){0.f, 0.f, 0.f, 0.f};
#pragma unroll
                for (int ks = 0; ks < 8; ++ks) {
#pragma unroll
                    for (int nb = 0; nb < 4; ++nb) {
                        const bf16x8 uf = *(const LAS bf16x8*)(useg + (16 * nb + l15) * 528 + (2 * ks + (s4 >> 1)) * 32 + 16 * (s4 & 1));
                        acc[nb] = __builtin_amdgcn_mfma_f32_16x16x32_bf16(ef[ks], uf, acc[nb], 0, 0, 0);
                    }
                    if (ks & 1) __builtin_amdgcn_sched_barrier(0);
                }
#pragma unroll
                for (int nb = 0; nb < 4; ++nb)
#pragma unroll
                    for (int j = 0; j < 4; ++j) lbuf[(16 * wave + 4 * s4 + j) * 65 + 16 * nb + l15] = acc[nb][j];
            }
            __syncthreads();
            LAS float* tend = (LAS float*)(lds + 2 * 33792 + 33280 + 17408);
            if (wave < 4) {
                float tr = 0.f, ti = 0.f;
#pragma unroll 4
                for (int i = 0; i < 16; ++i) {
                    const int o0 = lane * 65 + 16 * wave + i, o1 = (64 + lane) * 65 + 16 * wave + i;
                    const float lr = lbuf[o0], li = lbuf[o1];
                    lbuf[o0] = tr; lbuf[o1] = ti;
                    const float nr = l16r * tr - l16i * ti + lr, ni = l16r * ti + l16i * tr + li;
                    tr = nr; ti = ni;
                }
                tend[wave * 128 + lane] = tr; tend[wave * 128 + 64 + lane] = ti;
            }
            __syncthreads();
            if (wave < 4) {
                LAS bf16* sb16 = (LAS bf16*)sb;
                float cr = Sr, ci = Si, myr = 0.f, myi = 0.f;
#pragma unroll
                for (int j = 0; j < 4; ++j) {
                    if (j == wave) { myr = cr; myi = ci; }
                    const float er = tend[j * 128 + lane], ei2 = tend[j * 128 + 64 + lane];
                    const float nr = m16r * cr - m16i * ci + er, ni = m16r * ci + m16i * cr + ei2;
                    cr = nr; ci = ni;
                }
                Sr = cr; Si = ci;
                float pr = 1.f, pi = 0.f;
#pragma unroll 4
                for (int i = 0; i < 16; ++i) {
                    const float t_r = lbuf[lane * 65 + 16 * wave + i], t_i = lbuf[(64 + lane) * 65 + 16 * wave + i];
                    const float sr = t_r + pr * myr - pi * myi, si = t_i + pr * myi + pi * myr;
                    sb16[(16 * wave + i) * 136 + lane] = (bf16)f2bf(sr); sb16[(16 * wave + i) * 136 + 64 + lane] = (bf16)f2bf(si);
                    const float qr = pr * l16r - pi * l16i, qi = pr * l16i + pi * l16r; pr = qr; pi = qi;
                }
            }
            __syncthreads();
#pragma unroll
            for (int rr = 0; rr < 2; ++rr) {
                const int r = wave + 8 * rr;
                f32x4 acc[4];
#pragma unroll
                for (int nb = 0; nb < 4; ++nb) acc[nb] = (f32x4){0.f, 0.f, 0.f, 0.f};
#pragma unroll
                for (int ks = 0; ks < 4; ++ks) {
#pragma unroll
                    for (int nb = 0; nb < 4; ++nb) {
                        const bf16x8 sf = *(const LAS bf16x8*)(sb + (16 * nb + l15) * 272 + (32 * ks + 8 * s4) * 2);
                        acc[nb] = __builtin_amdgcn_mfma_f32_16x16x32_bf16(ff[rr][ks], sf, acc[nb], 0, 0, 0);
                    }
                    if (ks & 1) __builtin_amdgcn_sched_barrier(0);
                }
#pragma unroll
                for (int q = 0; q < 8; ++q) {
                    if ((rr == 1 || q < 4) && 2 * q <= r) {
#pragma unroll
                        for (int nb = 0; nb < 4; ++nb) {
                            const bf16x8 uf = *(const LAS bf16x8*)(useg + (16 * nb + l15) * 528 + (2 * q + (s4 >> 1)) * 32 + 16 * (s4 & 1));
                            acc[nb] = __builtin_amdgcn_mfma_f32_16x16x32_bf16(kf[rr][q], uf, acc[nb], 0, 0, 0);
                        }
                    }
                    if (q & 1) __builtin_amdgcn_sched_barrier(0);
                }
#pragma unroll
                for (int nb = 0; nb < 4; ++nb) {
                    const int sc = 16 * nb + l15;
                    const u32x2 uw = *(const LAS u32x2*)(useg + sc * 528 + r * 32 + 8 * s4);
                    const float y0 = acc[nb][0] + dco[0] * bflo(uw[0]), y1 = acc[nb][1] + dco[1] * bfhi(uw[0]), y2 = acc[nb][2] + dco[2] * bflo(uw[1]), y3 = acc[nb][3] + dco[3] * bfhi(uw[1]);
                    u32x2 o; o[0] = pk2(gelu_tanh(y0), gelu_tanh(y1)); o[1] = pk2(gelu_tanh(y2), gelu_tanh(y3));
                    *(u32x2*)(Z + (segtok0 + 16 * sc + r) * 1024 + g * 16 + 4 * s4) = o;
                }
            }
            if (seg < 3) {
#pragma unroll
                for (int i = 0; i < 2; ++i) {
                    const int t2 = tid + i * NTHREADS;
                    LAS unsigned char* dst = unext + (t2 >> 4) * 528 + (t2 & 15) * 32;
                    *(LAS u32x4*)dst = pf[2 * i]; *(LAS u32x4*)(dst + 16) = pf[2 * i + 1];
                }
            }
            __syncthreads();
        }
    }
}

__device__ __forceinline__ void ph_ysnorm(const Args& a) {
    int tid_ = threadIdx.x; asm volatile("" : "+v"(tid_));
    const int tid = tid_, lane = tid & 63, wave = tid >> 6;
    const int gw = blockIdx.x * NWAVES + wave, NGW = gridDim.x * NWAVES;
    const bf16* ys = (const bf16*)(a.ws + WS_YS); bf16* Y = (bf16*)(a.ws + WS_Y); const float* part = (const float*)(a.ws + WS_PARTS);
    for (int m = gw; m < NTOK; m += NGW) {
        float s = (lane < 16) ? part[(size_t)m * 16 + lane] : 0.f;
        const float rinv = __builtin_amdgcn_rsqf(wave_sum(s) * (1.0f / 1024.0f) + EPS);
#pragma unroll
        for (int j = 0; j < 2; ++j) {
            const u32x4 w = *(const u32x4*)(ys + (size_t)m * 1024 + 8 * (lane + 64 * j));
            u32x4 o;
#pragma unroll
            for (int e = 0; e < 4; ++e) o[e] = pk2(bflo(w[e]) * rinv, bfhi(w[e]) * rinv);
            *(u32x4*)(Y + (size_t)m * 2048 + 1024 + 8 * (lane + 64 * j)) = o;
        }
    }
}

__device__ __forceinline__ unsigned enc_key(float v) { const unsigned b = __builtin_bit_cast(unsigned, v); return b ^ ((b >> 31) ? 0xffffffffu : 0x80000000u); }
__device__ __forceinline__ float dec_key(unsigned o) { const unsigned b = (o & 0x80000000u) ? (o ^ 0x80000000u) : ~o; return __builtin_bit_cast(float, b); }
template <int CTRL> __device__ __forceinline__ unsigned dpp_u(unsigned v) { return (unsigned)__builtin_amdgcn_update_dpp(0, (int)v, CTRL, 0xf, 0xf, false); }
__device__ __forceinline__ unsigned row_umax(unsigned v) {
    unsigned t;
    t = dpp_u<0x128>(v); v = t > v ? t : v;
    t = dpp_u<0x124>(v); v = t > v ? t : v;
    t = dpp_u<0x122>(v); v = t > v ? t : v;
    t = dpp_u<0x121>(v); v = t > v ? t : v;
    return v;
}
#define CSWAP(x, y) do { const unsigned hi_ = (x) > (y) ? (x) : (y), lo_ = (x) > (y) ? (y) : (x); (x) = hi_; (y) = lo_; } while (0)
__device__ __forceinline__ void ph_topk(const Args& a, LAS unsigned char* lds) {
    int tid_ = threadIdx.x; asm volatile("" : "+v"(tid_));
    const int tid = tid_, lane = tid & 63, wave = __builtin_amdgcn_readfirstlane(tid >> 6), l15 = lane & 15, s4 = lane >> 4;
    const bf16* qp = (const bf16*)(a.ws + WS_Z);
    const bf16* keysb = (const bf16*)(a.ws + WS_KEYS);
    int* idxo = (int*)(a.ws + WS_YS); float* gateo = (float*)(a.ws + WS_YS + 4 * MiB);
    LAS float* sc = (LAS float*)(lds + wave * 16448);
    LAS unsigned* lst = (LAS unsigned*)(lds + 8 * 16448) + wave * 128 + s4 * 32;
    const int h = wave;
    bf16x8 kf[2][8][2];
#pragma unroll
    for (int side = 0; side < 2; ++side)
#pragma unroll
        for (int nbl = 0; nbl < 8; ++nbl)
#pragma unroll
            for (int ks = 0; ks < 2; ++ks) kf[side][nbl][ks] = *(const bf16x8*)(keysb + ((size_t)((h * 2 + side) * 128 + 16 * nbl + l15)) * 64 + 32 * ks + 8 * s4);
    for (int item = blockIdx.x; item < NTOK / 32; item += gridDim.x) {
#pragma unroll 1
        for (int sub = 0; sub < 2; ++sub) {
            const int t0 = item * 32 + sub * 16;
            bf16x8 qf[2][2];
#pragma unroll
            for (int side = 0; side < 2; ++side)
#pragma unroll
                for (int ks = 0; ks < 2; ++ks) qf[side][ks] = *(const bf16x8*)(qp + (size_t)(t0 + l15) * 1024 + h * 128 + side * 64 + 32 * ks + 8 * s4);
#pragma unroll
            for (int side = 0; side < 2; ++side)
#pragma unroll
                for (int nbl = 0; nbl < 8; ++nbl) {
                    f32x4 c = {0.f, 0.f, 0.f, 0.f};
#pragma unroll
                    for (int ks = 0; ks < 2; ++ks) c = __builtin_amdgcn_mfma_f32_16x16x32_bf16(qf[side][ks], kf[side][nbl][ks], c, 0, 0, 0);
#pragma unroll
                    for (int j = 0; j < 4; ++j) sc[(4 * s4 + j) * 257 + side * 128 + 16 * nbl + l15] = c[j];
                }
            asm volatile("s_waitcnt lgkmcnt(0)" ::: "memory");
#pragma unroll 1
            for (int tt = 0; tt < 4; ++tt) {
                const int tl = tt * 4 + s4; const LAS float* sr = sc + tl * 257;
                unsigned top[2];
#pragma unroll
                for (int side = 0; side < 2; ++side) {
                    unsigned v[8];
#pragma unroll
                    for (int k = 0; k < 8; ++k) v[k] = (enc_key(sr[side * 128 + l15 + 16 * k]) & ~127u) | (unsigned)(127 - (l15 + 16 * k));
                    CSWAP(v[0], v[1]); CSWAP(v[2], v[3]); CSWAP(v[4], v[5]); CSWAP(v[6], v[7]);
                    CSWAP(v[0], v[2]); CSWAP(v[1], v[3]); CSWAP(v[4], v[6]); CSWAP(v[5], v[7]);
                    CSWAP(v[1], v[2]); CSWAP(v[5], v[6]); CSWAP(v[0], v[4]); CSWAP(v[3], v[7]);
                    CSWAP(v[1], v[5]); CSWAP(v[2], v[6]);
                    CSWAP(v[1], v[4]); CSWAP(v[3], v[6]);
                    CSWAP(v[2], v[4]); CSWAP(v[3], v[5]);
                    CSWAP(v[3], v[4]);
                    unsigned mine = 0u;
#pragma unroll
                    for (int it = 0; it < 16; ++it) {
                        const unsigned m = row_umax(v[0]);
                        const bool win = v[0] == m;
#pragma unroll
                        for (int k = 0; k < 7; ++k) v[k] = win ? v[k + 1] : v[k];
                        v[7] = win ? 0u : v[7];
                        mine = (l15 == it) ? m : mine;
                    }
                    top[side] = mine;
                }
                lst[l15] = top[0]; lst[16 + l15] = top[1];
                asm volatile("s_waitcnt lgkmcnt(0)" ::: "memory");
                const float s1 = dec_key(top[0] & ~127u);
                unsigned c[16];
#pragma unroll
                for (int q = 0; q < 4; ++q) {
                    const u32x4 w = *(const LAS u32x4*)(lst + 16 + 4 * q);
#pragma unroll
                    for (int k = 0; k < 4; ++k) c[4 * q + k] = (enc_key(s1 + dec_key(w[k] & ~127u)) & ~255u) | (unsigned)(255 - (l15 * 16 + 4 * q + k));
                }
                unsigned mine = 0u;
#pragma unroll
                for (int it = 0; it < 16; ++it) {
                    const unsigned m = row_umax(c[0]);
                    const bool win = c[0] == m;
#pragma unroll
                    for (int k = 0; k < 15; ++k) c[k] = win ? c[k + 1] : c[k];
                    c[15] = win ? 0u : c[15];
                    mine = (l15 == it) ? m : mine;
                }
                const float val = dec_key(mine & ~255u);
                float vm = val;
                { float t;
                  t = __builtin_bit_cast(float, dpp_u<0x128>(__builtin_bit_cast(unsigned, vm))); vm = fmaxf(vm, t);
                  t = __builtin_bit_cast(float, dpp_u<0x124>(__builtin_bit_cast(unsigned, vm))); vm = fmaxf(vm, t);
                  t = __builtin_bit_cast(float, dpp_u<0x122>(__builtin_bit_cast(unsigned, vm))); vm = fmaxf(vm, t);
                  t = __builtin_bit_cast(float, dpp_u<0x121>(__builtin_bit_cast(unsigned, vm))); vm = fmaxf(vm, t); }
                const float ex = __expf(val - vm);
                float sm = ex;
                { float t;
                  t = __builtin_bit_cast(float, dpp_u<0x128>(__builtin_bit_cast(unsigned, sm))); sm += t;
                  t = __builtin_bit_cast(float, dpp_u<0x124>(__builtin_bit_cast(unsigned, sm))); sm += t;
                  t = __builtin_bit_cast(float, dpp_u<0x122>(__builtin_bit_cast(unsigned, sm))); sm += t;
                  t = __builtin_bit_cast(float, dpp_u<0x121>(__builtin_bit_cast(unsigned, sm))); sm += t; }
                {
                    const int cand = 255 - (int)(mine & 255u), ia = cand >> 4, ib = cand & 15;
                    const int i1 = 127 - (int)(lst[ia] & 127u), i2 = 127 - (int)(lst[16 + ib] & 127u);
                    const int jp = h * 16 + l15;
                    const size_t o = (size_t)(t0 + tl) * 128 + (jp & 7) * 16 + (jp >> 3);
                    idxo[o] = i1 * 128 + i2; gateo[o] = ex * __builtin_amdgcn_rcpf(sm);
                }
                asm volatile("s_waitcnt lgkmcnt(0)" ::: "memory");
            }
        }
    }
}

__device__ __forceinline__ float cvt_ub(unsigned w, int k) { return (float)((w >> (8 * k)) & 0xffu); }
template <int CTRL> __device__ __forceinline__ float dpp_f(float v) { return __builtin_bit_cast(float, __builtin_amdgcn_update_dpp(0, __builtin_bit_cast(int, v), CTRL, 0xf, 0xf, false)); }
#define PP_LOAD_IDX(ei, tok) do { _Pragma("unroll") for (int q_ = 0; q_ < 4; ++q_) { const u32x4 t_ = *(const u32x4*)(idx + (size_t)(tok) * 128 + pr * 16 + 4 * q_); \
        ei[4 * q_] = (int)t_[0]; ei[4 * q_ + 1] = (int)t_[1]; ei[4 * q_ + 2] = (int)t_[2]; ei[4 * q_ + 3] = (int)t_[3]; } } while (0)
#define PP_G8(ub, ei, o8) do { _Pragma("unroll") for (int i_ = 0; i_ < 8; ++i_) ub[i_] = *(const u32x4*)(slab + ((unsigned)ei[(o8) + i_] * 128u + coff)); } while (0)
#define PU_LOAD_H(hx, tok) do { hx[0] = *(const u32x4*)(h2b + (size_t)(tok) * 2048 + 128 * s + 16 * c); hx[1] = *(const u32x4*)(h2b + (size_t)(tok) * 2048 + 128 * s + 16 * c + 8); } while (0)
template <int CTRL> __device__ __forceinline__ int dpp_i(int v) { return __builtin_amdgcn_update_dpp(0, v, CTRL, 0xf, 0xf, false); }
#define PU_QUANT(hx, hq, hs) do { \
        float f_[16]; _Pragma("unroll") for (int q_ = 0; q_ < 2; ++q_) _Pragma("unroll") for (int e_ = 0; e_ < 4; ++e_) { f_[8 * q_ + 2 * e_] = bflo(hx[q_][e_]); f_[8 * q_ + 2 * e_ + 1] = bfhi(hx[q_][e_]); } \
        float m_ = 0.f; _Pragma("unroll") for (int k_ = 0; k_ < 16; ++k_) m_ = fmaxf(m_, fabsf(f_[k_])); \
        m_ = fmaxf(m_, dpp_f<0xB1>(m_)); m_ = fmaxf(m_, dpp_f<0x4E>(m_)); m_ = fmaxf(m_, dpp_f<0x141>(m_)); m_ = fmaxf(m_, 1e-30f); \
        const float iv_ = 127.0f * __builtin_amdgcn_rcpf(m_); hs = m_ * (1.0f / 127.0f); \
        _Pragma("unroll") for (int q_ = 0; q_ < 4; ++q_) { \
            const int a0_ = (int)rintf(f_[4 * q_] * iv_), a1_ = (int)rintf(f_[4 * q_ + 1] * iv_), a2_ = (int)rintf(f_[4 * q_ + 2] * iv_), a3_ = (int)rintf(f_[4 * q_ + 3] * iv_); \
            hq[q_] = (int)(((unsigned)a0_ & 0xffu) | (((unsigned)a1_ & 0xffu) << 8) | (((unsigned)a2_ & 0xffu) << 16) | ((unsigned)a3_ << 24)); } } while (0)
#define PU_C8(ub, hq, hs, res) do { \
        _Pragma("unroll") for (int i_ = 0; i_ < 8; ++i_) { \
            int d_ = 0; \
            _Pragma("unroll") for (int q_ = 0; q_ < 4; ++q_) d_ = __builtin_amdgcn_sdot4((int)ub[i_][q_], hq[q_], d_, false); \
            d_ += dpp_i<0xB1>(d_); d_ += dpp_i<0x4E>(d_); d_ += dpp_i<0x141>(d_); \
            res = (c == i_) ? (float)d_ * hs : res; } } while (0)
#define PU_STORE(tok, k_, r0, r1) do { LAS float* lp_ = keep + (k_) * 128 + lane; \
        if (pass == 0) { lp_[0] = r0; lp_[64] = r1; } \
        else { float* po_ = pu + ((size_t)x * NTOK + (tok)) * 128 + pr * 16 + c; po_[0] = r0 + lp_[0]; po_[8] = r1 + lp_[64]; } } while (0)
__device__ __forceinline__ void ph_peer_u(const Args& a, LAS unsigned char* lds) {
    int tid_ = threadIdx.x; asm volatile("" : "+v"(tid_));
    const int tid = tid_, lane = tid & 63, wave = tid >> 6, pr = lane >> 3, c = lane & 7;
    const bf16* h2b = (const bf16*)(a.ws + WS_AB);
    const unsigned char* Uq = a.ws + WS_UB;
    const int* idx = (const int*)(a.ws + WS_YS);
    float* pu = (float*)(a.ws + WS_PU);
    const int x = blockIdx.x & 7, nbx = gridDim.x >> 3, bi = blockIdx.x >> 3;
    const int tstride = nbx * NWAVES, tfirst = bi * NWAVES + wave, ntok = NTOK / tstride;
    LAS float* keep = (LAS float*)(lds + wave * 16384);
    const unsigned coff = 16u * (unsigned)c;
    for (int pass = 0; pass < 2; ++pass) {
        const int s = x + 8 * pass;
        const unsigned char* slab = Uq + (size_t)s * PE * 128;
        int eA[16], eB[16]; u32x4 ub0[8], ub1[8]; u32x4 hA[2], hB[2];
        PP_LOAD_IDX(eA, tfirst);
        PP_G8(ub0, eA, 0); PU_LOAD_H(hA, tfirst);
        PP_LOAD_IDX(eB, tfirst + tstride);
        for (int k = 0; k < ntok; k += 2) {
            const int tokA = tfirst + k * tstride, tokB = tokA + tstride;
            const bool more = k + 2 < ntok;
            float r0 = 0.f, r1 = 0.f; int hq[4]; float hs;
            PP_G8(ub1, eA, 8);
            if (more) PP_LOAD_IDX(eA, tokA + 2 * tstride);
            PU_QUANT(hA, hq, hs);
            PU_C8(ub0, hq, hs, r0);
            PP_G8(ub0, eB, 0); PU_LOAD_H(hB, tokB);
            PU_C8(ub1, hq, hs, r1);
            PU_STORE(tokA, k, r0, r1);
            r0 = 0.f; r1 = 0.f;
            PP_G8(ub1, eB, 8);
            if (more) PP_LOAD_IDX(eB, tokB + 2 * tstride);
            PU_QUANT(hB, hq, hs);
            PU_C8(ub0, hq, hs, r0);
            if (more) { PP_G8(ub0, eA, 0); PU_LOAD_H(hA, tokA + 2 * tstride); }
            PU_C8(ub1, hq, hs, r1);
            PU_STORE(tokB, k + 1, r0, r1);
        }
    }
}
__device__ __forceinline__ void ph_peer_w(const Args& a) {
    int tid_ = threadIdx.x; asm volatile("" : "+v"(tid_));
    const int tid = tid_, lane = tid & 63, wave = tid >> 6;
    const float* part = (const float*)(a.ws + WS_PART2);
    const float* su = (const float*)(a.ws + WS_QSC); const float* sv = su + PE;
    const int* idx = (const int*)(a.ws + WS_YS); const float* gate = (const float*)(a.ws + WS_YS + 4 * MiB);
    const float* pu = (const float*)(a.ws + WS_PU);
    unsigned char* wq = (unsigned char*)(a.ws + WS_WP); float* wsc = (float*)(a.ws + WS_WSUM);
    for (int tok = blockIdx.x * NWAVES + wave; tok < NTOK; tok += gridDim.x * NWAVES) {
        const float ps = (lane < 32) ? part[(size_t)tok * 32 + lane] : 0.f;
        const float rinv = __builtin_amdgcn_rsqf(wave_sum(ps) * (1.0f / 2048.0f) + EPS);
        float w[2]; float mx = 0.f;
#pragma unroll
        for (int hh = 0; hh < 2; ++hh) {
            const int pos = lane + 64 * hh;
            float d = 0.f;
#pragma unroll
            for (int s = 0; s < 8; ++s) d += pu[((size_t)s * NTOK + tok) * 128 + pos];
            const int e = idx[(size_t)tok * 128 + pos];
            w[hh] = gate[(size_t)tok * 128 + pos] * gelu_tanh(d * rinv * su[e]) * sv[e];
            mx = fmaxf(mx, fabsf(w[hh]));
        }
#pragma unroll
        for (int o = 1; o < 64; o <<= 1) mx = fmaxf(mx, __shfl_xor(mx, o));
        mx = fmaxf(mx, 1e-30f);
        const float iv = 127.0f * __builtin_amdgcn_rcpf(mx);
#pragma unroll
        for (int hh = 0; hh < 2; ++hh) wq[(size_t)tok * 128 + lane + 64 * hh] = (unsigned char)((int)rintf(w[hh] * iv) & 0xff);
        if (lane == 0) wsc[tok] = mx * (1.0f / 127.0f);
    }
}
#define PV_LOAD_W(wv, tok) do { wv = *(const u32x4*)(wq + (size_t)(tok) * 128 + pr * 16); } while (0)
#define PV_G4(r0, r1, r2, r3, wd, acc) do { _Pragma("unroll") for (int q_ = 0; q_ < 4; ++q_) { \
        const unsigned l01_ = __builtin_amdgcn_perm(r1[q_], r0[q_], 0x05010400u), l23_ = __builtin_amdgcn_perm(r3[q_], r2[q_], 0x05010400u); \
        const unsigned h01_ = __builtin_amdgcn_perm(r1[q_], r0[q_], 0x07030602u), h23_ = __builtin_amdgcn_perm(r3[q_], r2[q_], 0x07030602u); \
        acc[4 * q_ + 0] = __builtin_amdgcn_sdot4((int)__builtin_amdgcn_perm(l23_, l01_, 0x05040100u), (int)(wd), acc[4 * q_ + 0], false); \
        acc[4 * q_ + 1] = __builtin_amdgcn_sdot4((int)__builtin_amdgcn_perm(l23_, l01_, 0x07060302u), (int)(wd), acc[4 * q_ + 1], false); \
        acc[4 * q_ + 2] = __builtin_amdgcn_sdot4((int)__builtin_amdgcn_perm(h23_, h01_, 0x05040100u), (int)(wd), acc[4 * q_ + 2], false); \
        acc[4 * q_ + 3] = __builtin_amdgcn_sdot4((int)__builtin_amdgcn_perm(h23_, h01_, 0x07060302u), (int)(wd), acc[4 * q_ + 3], false); } } while (0)
#define PV_C8(vb, wv, o8, acc) do { PV_G4(vb[0], vb[1], vb[2], vb[3], wv[(o8) / 4], acc); PV_G4(vb[4], vb[5], vb[6], vb[7], wv[(o8) / 4 + 1], acc); } while (0)
#define PV_FINISH(acc, tok) do { \
        int r8_[8]; _Pragma("unroll") for (int k_ = 0; k_ < 8; ++k_) { const int m_ = b2 ? acc[k_ + 8] : acc[k_], o_ = b2 ? acc[k_] : acc[k_ + 8]; r8_[k_] = m_ + __shfl_xor(o_, 32); } \
        int r4_[4]; _Pragma("unroll") for (int k_ = 0; k_ < 4; ++k_) { const int m_ = b1 ? r8_[k_ + 4] : r8_[k_], o_ = b1 ? r8_[k_] : r8_[k_ + 4]; r4_[k_] = m_ + __shfl_xor(o_, 16); } \
        int r2_[2]; _Pragma("unroll") for (int k_ = 0; k_ < 2; ++k_) { const int m_ = b0 ? r4_[k_ + 2] : r4_[k_], o_ = b0 ? r4_[k_] : r4_[k_ + 2]; r2_[k_] = m_ + __shfl_xor(o_, 8); } \
        const float ws_ = wsc[(tok)]; \
        const size_t ho_ = (size_t)(tok) * 2048 + 128 * s + 16 * c + 2 * pr; \
        const unsigned hx_ = *(const unsigned*)(h2b + ho_); \
        const float o0_ = bflo(hx_) + (float)r2_[0] * ws_, o1_ = bfhi(hx_) + (float)r2_[1] * ws_; \
        *(f32x2*)(h3 + ho_) = (f32x2){o0_, o1_}; \
        const float ss_ = wave_sum(o0_ * o0_ + o1_ * o1_); \
        if (lane == 0) partf[(size_t)(tok) * 16 + s] = ss_; \
        _Pragma("unroll") for (int k_ = 0; k_ < 16; ++k_) acc[k_] = 0; } while (0)
__device__ __forceinline__ void ph_peer_v(const Args& a) {
    int tid_ = threadIdx.x; asm volatile("" : "+v"(tid_));
    const int tid = tid_, lane = tid & 63, wave = tid >> 6, pr = lane >> 3, c = lane & 7;
    const bf16* h2b = (const bf16*)(a.ws + WS_AB); float* h3 = (float*)(a.ws + WS_H);
    const unsigned char* Vq = a.ws + WS_VB;
    const int* idx = (const int*)(a.ws + WS_YS);
    const unsigned char* wq = (const unsigned char*)(a.ws + WS_WP); const float* wsc = (const float*)(a.ws + WS_WSUM);
    float* partf = (float*)(a.ws + WS_PARTF);
    const int x = blockIdx.x & 7, nbx = gridDim.x >> 3, bi = blockIdx.x >> 3;
    const bool b2 = (pr & 4) != 0, b1 = (pr & 2) != 0, b0 = (pr & 1) != 0;
    const int tstride = nbx * NWAVES, tfirst = bi * NWAVES + wave, ntok = NTOK / tstride;
    const unsigned coff = 16u * (unsigned)c;
    for (int pass = 0; pass < 2; ++pass) {
        const int s = x + 8 * pass;
        const unsigned char* slab = Vq + (size_t)s * PE * 128;
        int eA[16], eB[16]; u32x4 ub0[8], ub1[8]; u32x4 wA, wB; int acc[16];
#pragma unroll
        for (int k = 0; k < 16; ++k) acc[k] = 0;
        PP_LOAD_IDX(eA, tfirst);
        PP_G8(ub0, eA, 0); PV_LOAD_W(wA, tfirst);
        PP_LOAD_IDX(eB, tfirst + tstride);
        for (int k = 0; k < ntok; k += 2) {
            const int tokA = tfirst + k * tstride, tokB = tokA + tstride;
            const bool more = k + 2 < ntok;
            PP_G8(ub1, eA, 8);
            if (more) PP_LOAD_IDX(eA, tokA + 2 * tstride);
            PV_C8(ub0, wA, 0, acc);
            PP_G8(ub0, eB, 0); PV_LOAD_W(wB, tokB);
            PV_C8(ub1, wA, 8, acc);
            PV_FINISH(acc, tokA);
            PP_G8(ub1, eB, 8);
            if (more) PP_LOAD_IDX(eB, tokB + 2 * tstride);
            PV_C8(ub0, wB, 0, acc);
            if (more) { PP_G8(ub0, eA, 0); PV_LOAD_W(wA, tokA + 2 * tstride); }
            PV_C8(ub1, wB, 8, acc);
            PV_FINISH(acc, tokB);
        }
    }
}
__device__ __forceinline__ void ph_final(const Args& a) {
    int tid_ = threadIdx.x; asm volatile("" : "+v"(tid_));
    const int tid = tid_, lane = tid & 63, wave = tid >> 6;
    const float* h3 = (const float*)(a.ws + WS_H); const float* partf = (const float*)(a.ws + WS_PARTF); const float* gfin = a.in[30];
    const int step = gridDim.x * NWAVES;
#define FN_LOAD(v, ps, tok) do { ps = (lane < 16) ? partf[(size_t)(tok) * 16 + lane] : 0.f; \
        _Pragma("unroll") for (int j_ = 0; j_ < 8; ++j_) v[j_] = __builtin_nontemporal_load((const f32x4*)(h3 + (size_t)(tok) * 2048 + 4 * (lane + 64 * j_))); } while (0)
#define FN_PROC(v, ps, tok) do { const float rf_ = __builtin_amdgcn_rsqf(wave_sum(ps) * (1.0f / 2048.0f) + EPS); \
        _Pragma("unroll") for (int j_ = 0; j_ < 8; ++j_) { const f32x4 g_ = *(const f32x4*)(gfin + 4 * (lane + 64 * j_)); \
            __builtin_nontemporal_store(v[j_] * g_ * rf_, (f32x4*)(a.out + (size_t)(tok) * 2048 + 4 * (lane + 64 * j_))); } } while (0)
    f32x4 va[8], vb[8]; float pa = 0.f, pb = 0.f;
    int tok = blockIdx.x * NWAVES + wave;
    if (tok < NTOK) FN_LOAD(va, pa, tok);
    for (; tok < NTOK; tok += 2 * step) {
        const int tn = tok + step;
        if (tn < NTOK) FN_LOAD(vb, pb, tn);
        FN_PROC(va, pa, tok);
        if (tn < NTOK) {
            if (tn + step < NTOK) FN_LOAD(va, pa, tn + step);
            FN_PROC(vb, pb, tn);
        }
    }
#undef FN_LOAD
#undef FN_PROC
}

#define XB_TMO      128
#define XB_XCNT(j)  (256  + 64 * (j))
#define XB_XSUB(j)  (1280 + 64 * (j))
#define XB_XGEN(j)  (2304 + 64 * (j))
#define XB_TOP      3328
#define XB_TOPGEN   3392
#define XCD_BAR_WORDS 3456
#define XB_SPIN_CAP (1u << 18)
__device__ __forceinline__ unsigned xb_ld(unsigned* p)              { return __hip_atomic_load(p, __ATOMIC_RELAXED, __HIP_MEMORY_SCOPE_AGENT); }
__device__ __forceinline__ unsigned xb_add(unsigned* p, unsigned v) { return __hip_atomic_fetch_add(p, v, __ATOMIC_RELAXED, __HIP_MEMORY_SCOPE_AGENT); }
__device__ __forceinline__ unsigned xb_xcc_id() { return (unsigned)__builtin_amdgcn_s_getreg((3 << 11) | 20) & 0xFu; }
#define XB_SPIN(cond, bar) do { unsigned _sp = 0; while (cond) { __builtin_amdgcn_s_sleep(1); \
    if ((++_sp & 255u) == 0u) { if (xb_ld(&(bar)[XB_TMO])) break; if (_sp > XB_SPIN_CAP) { atomicAdd(&(bar)[XB_TMO], 1u); break; } } } } while (0)
struct XcdBarrier { unsigned* bar; unsigned x; volatile LAS unsigned* st; };
__device__ __forceinline__ XcdBarrier xcd_barrier_post(unsigned* bar, volatile LAS unsigned* st) {
    XcdBarrier b; b.bar = bar; b.x = xb_xcc_id(); b.st = st;
    if (threadIdx.x == 0) (void)xb_add(&bar[XB_XCNT(b.x)], 1u);
    return b;
}
__device__ __forceinline__ void xcd_barrier_complete(unsigned* bar, unsigned x, unsigned& nloc, unsigned& nx) {
    const unsigned G = gridDim.x * gridDim.y * gridDim.z;
    unsigned sum, cnt, mine, sp = 0u;
    for (;;) {
        sum = 0u; cnt = 0u; mine = 0u;
#pragma unroll
        for (unsigned j = 0; j < 16; ++j) { const unsigned c = xb_ld(&bar[XB_XCNT(j)]); sum += c; cnt += (c > 0u) ? 1u : 0u; mine = (j == x) ? c : mine; }
        if (sum == G) break;
        __builtin_amdgcn_s_sleep(1);
        if ((++sp & 255u) == 0u) { if (xb_ld(&bar[XB_TMO])) break; if (sp > XB_SPIN_CAP) { atomicAdd(&bar[XB_TMO], 1u); break; } }
    }
    nloc = mine > 0u ? mine : 1u; nx = cnt > 0u ? cnt : 1u;
}
__device__ __forceinline__ void xcd_barrier(const XcdBarrier& b) {
    asm volatile("s_waitcnt vmcnt(0)" ::: "memory");
    __syncthreads();
    if (threadIdx.x == 0) {
        unsigned* bar = b.bar;
        __builtin_amdgcn_s_waitcnt(0);
        unsigned nloc = b.st[0], nx = b.st[1];
        if (nloc == 0u) { xcd_barrier_complete(bar, b.x, nloc, nx); b.st[0] = nloc; b.st[1] = nx; }
        const unsigned old = xb_add(&bar[XB_XSUB(b.x)], 1u);
        const unsigned gen = old / nloc;
        if (old + 1u == (gen + 1u) * nloc) {
            __builtin_amdgcn_fence(__ATOMIC_RELEASE, "agent");
            asm volatile("s_waitcnt vmcnt(0)" ::: "memory");
            const unsigned og = xb_add(&bar[XB_TOP], 1u);
            const unsigned tg = og / nx;
            if (og + 1u == (tg + 1u) * nx) xb_add(&bar[XB_TOPGEN], 1u);
            else XB_SPIN(xb_ld(&bar[XB_TOPGEN]) == tg, bar);
            __builtin_amdgcn_fence(__ATOMIC_ACQUIRE, "agent");
            xb_add(&bar[XB_XGEN(b.x)], 1u);
            asm volatile("s_waitcnt vmcnt(0)" ::: "memory");
        } else {
            XB_SPIN(xb_ld(&bar[XB_XGEN(b.x)]) == gen, bar);
            __builtin_amdgcn_fence(__ATOMIC_ACQUIRE, "agent");
            asm volatile("s_waitcnt vmcnt(0)" ::: "memory");
        }
    }
    __syncthreads();
}

constexpr int MISC_OFF = LDS_BYTES - 128;
constexpr size_t CTL_ZERO_BYTES = 65536;
__global__ void __launch_bounds__(NTHREADS, 2) __attribute__((target("no-packed-fp32-ops"))) mk_fwd(Args a) {
    extern __shared__ __attribute__((aligned(16))) unsigned char lds_raw[];
    LAS unsigned char* lds = (LAS unsigned char*)lds_raw;
    unsigned char* ws = a.ws;
    for (int u = threadIdx.x; u < 32; u += NTHREADS) ((LAS unsigned*)(lds + MISC_OFF))[u] = 0u;
    __syncthreads();
    (void)xcd_barrier_post((unsigned*)(ws + WS_CTL), (volatile LAS unsigned*)(lds + MISC_OFF) + 8);
#define GRID_BAR() do { XcdBarrier bar_; bar_.bar = (unsigned*)(a.ws + WS_CTL); bar_.x = xb_xcc_id(); bar_.st = (volatile LAS unsigned*)(lds + MISC_OFF) + 8; xcd_barrier(bar_); } while (0)
    ph_prologue(a, lds);
    GRID_BAR();
    {
        { Epi<0> E{nullptr, nullptr, (bf16*)(ws + WS_PROJ), NIN, 1.0f, nullptr, 0, nullptr, nullptr, nullptr, nullptr, 0};
          run_gemm(lds, (const bf16*)(ws + WS_AB), (const bf16*)(ws + WS_WIN), NTOK, NIN, 2048, E); }
        { Epi<0> E{nullptr, nullptr, (bf16*)(ws + WS_KV), 4096, 1.0f, nullptr, 0, nullptr, nullptr, nullptr, nullptr, 0};
          run_gemm(lds, (const bf16*)(ws + WS_MEMN), (const bf16*)(ws + WS_WKV), NMEMTOK, 4096, 2048, E, 128); }
        if (blockIdx.x >= 160) quant_rows(a, ((int)blockIdx.x - 160) * 64, ((int)blockIdx.x - 160) * 64 + 64);
    }
    GRID_BAR();
    ph_conv(a, lds);
    ph_s5(a, lds);
    GRID_BAR();
    {
        { Epi<1> E{nullptr, nullptr, (bf16*)(ws + WS_Y), 2048, 1.0f, nullptr, 0, (const bf16*)(ws + WS_Z), nullptr, nullptr, (float*)(ws + WS_PARTS), 16};
          run_gemm(lds, (const bf16*)(ws + WS_Z), (const bf16*)(ws + WS_WGLU), NTOK, 1024, 1024, E); }
        const bf16* kv = (const bf16*)(ws + WS_KV);
        for (int bh = 0; bh < 8; ++bh) {
            const int b = bh >> 2, h = bh & 3;
            Epi<0> E{nullptr, nullptr, (bf16*)(ws + WS_G) + ((size_t)b * 1024 + h * 256) * 2048, 2048, 1.0f, nullptr, 0, nullptr, nullptr, nullptr, nullptr, 0};
            run_gemm(lds, kv + (size_t)b * 256 * 4096 + h * 512, (const bf16*)(ws + WS_WQ) + h * 512, 256, 2048, 512, E, 128 + 8 * bh, 4096, 2048);
        }
        for (int bh = 0; bh < 8; ++bh) {
            const int b = bh >> 2, h = bh & 3;
            Epi<0> E{nullptr, nullptr, (bf16*)(ws + WS_HC) + (size_t)b * 2048 * 1024 + h * 256, 1024, 1.0f, nullptr, 0, nullptr, nullptr, nullptr, nullptr, 0};
            run_gemm(lds, (const bf16*)(ws + WS_WO) + h * 512, kv + (size_t)b * 256 * 4096 + 2048 + h * 512, 2048, 256, 512, E, 192 + 8 * bh, 2048, 4096);
        }
    }
    GRID_BAR();
    {
        {
            const int c0 = (int)blockIdx.x, wg0 = (c0 & 7) * 32 + (c0 >> 3), pm0 = (wg0 >> 6) * 8 + ((wg0 & 63) & 7);
            const float* mp = (const float*)(ws + WS_PARTS);
            if (threadIdx.x < 256) {
                const int row = pm0 * 256 + (int)threadIdx.x; float s = 0.f;
#pragma unroll
                for (int i = 0; i < 16; i += 4) { const f32x4 v = *(const f32x4*)(mp + (size_t)row * 16 + i); s += (v[0] + v[1]) + (v[2] + v[3]); }
                ((LAS float*)(lds + 131072))[threadIdx.x] = __builtin_amdgcn_rsqf(s * (1.0f / 1024.0f) + EPS);
            }
            __syncthreads();
        }
        Epi<2, true> E{(const float*)(ws + WS_PARTS), lds + 131072, (bf16*)(ws + WS_AB), 2048, 1.0f, nullptr, 0, nullptr, a.in[0], nullptr, (float*)(ws + WS_PART1), 32};
        run_gemm(lds, (const bf16*)(ws + WS_Y), (const bf16*)(ws + WS_WOUT), NTOK, 2048, 2048, E);
    }
    GRID_BAR();
    {
        for (int b = 0; b < 2; ++b) {
            EpiSoftmax E{(bf16*)(ws + WS_P) + (size_t)b * SEQ * 1024, 1024, (const float*)(ws + WS_PART1) + (size_t)b * SEQ * 32, 0.044194173824159216f};
            run_gemm<EpiSoftmax, false>(lds, (const bf16*)(ws + WS_AB) + (size_t)b * SEQ * 2048, (const bf16*)(ws + WS_G) + (size_t)b * 1024 * 2048, SEQ, 1024, 2048, E, 64 * b);
        }
        if (blockIdx.x >= 128) quant_rows(a, 6144 + ((int)blockIdx.x - 128) * 104, 6144 + ((int)blockIdx.x - 128) * 104 + 104);
    }
    GRID_BAR();
    {
        for (int b = 0; b < 2; ++b) {
            Epi<2> E{nullptr, nullptr, (bf16*)(ws + WS_AB) + (size_t)b * SEQ * 2048, 2048, 1.0f, nullptr, 0, (const bf16*)(ws + WS_AB) + (size_t)b * SEQ * 2048, nullptr, nullptr, (float*)(ws + WS_PART2) + (size_t)b * SEQ * 32, 32};
            run_gemm(lds, (const bf16*)(ws + WS_P) + (size_t)b * SEQ * 1024, (const bf16*)(ws + WS_HC) + (size_t)b * 2048 * 1024, SEQ, 2048, 1024, E, 128 * b);
        }
    }
    GRID_BAR();
    {
        Epi<0> E{nullptr, nullptr, (bf16*)(ws + WS_Z), 1024, 1.0f, (const float*)(ws + WS_PART2), 32, nullptr, nullptr, nullptr, nullptr, 0};
        run_gemm(lds, (const bf16*)(ws + WS_AB), (const bf16*)(ws + WS_WPQ), NTOK, 1024, 2048, E);
        if (blockIdx.x >= 128) quant_rows(a, 19456 + ((int)blockIdx.x - 128) * 104, 19456 + ((int)blockIdx.x - 128) * 104 + 104);
    }
    GRID_BAR();
    ph_topk(a, lds);
    GRID_BAR();
    ph_peer_u(a, lds);
    GRID_BAR();
    ph_peer_w(a);
    GRID_BAR();
    ph_peer_v(a);
    GRID_BAR();
    ph_final(a);
}

extern "C" void kernel_launch(void* const* d_in, const int* in_sizes, int n_in, void* d_out, int out_size, void* d_ws, size_t ws_size, hipStream_t stream) {
    if (n_in != 31 || ws_size < WS_END) { fprintf(stderr, "kernel_launch: unexpected inputs (n_in %d, ws %zu)\n", n_in, ws_size); return; }
    static int grid = 0;
    if (grid == 0) {
        int dev = 0, cus = 0, per_cu = 0;
        if (hipGetDevice(&dev) != hipSuccess || hipDeviceGetAttribute(&cus, hipDeviceAttributeMultiprocessorCount, dev) != hipSuccess) { grid = -1; return; }
        if (hipFuncSetAttribute((const void*)mk_fwd, hipFuncAttributeMaxDynamicSharedMemorySize, LDS_BYTES) != hipSuccess) { grid = -1; return; }
        if (hipOccupancyMaxActiveBlocksPerMultiprocessor(&per_cu, (const void*)mk_fwd, NTHREADS, LDS_BYTES) != hipSuccess || per_cu < 1) { fprintf(stderr, "kernel_launch: occupancy query says %d\n", per_cu); }
        (void)hipGetLastError();
        grid = 256;
        if (cus != 256) fprintf(stderr, "kernel_launch: built for 256 CUs, device reports %d\n", cus);
    }
    if (grid < 0) return;
    (void)hipMemsetAsync((char*)d_ws + WS_CTL, 0, CTL_ZERO_BYTES, stream);
    Args a{};
    for (int i = 0; i < 31; ++i) a.in[i] = (const float*)d_in[i];
    a.out = (float*)d_out; a.ws = (unsigned char*)d_ws;
    hipLaunchKernelGGL(mk_fwd, dim3(grid), dim3(NTHREADS), LDS_BYTES, stream, a);
}
```

```cpp
#include <hip/hip_runtime.h>
#include <cstdio>
#include <cstdint>
namespace pg8 {
#define PG8_LAS __attribute__((address_space(3)))
typedef unsigned short bf16_t;
typedef short bf16x8 __attribute__((ext_vector_type(8)));
typedef float f32x4 __attribute__((ext_vector_type(4)));
typedef unsigned u32x4 __attribute__((ext_vector_type(4)));
constexpr int BM = 256, BK = 64, HALF = 128, HTB = HALF * BK * 2  , STAGE_BYTES = 8 * HTB, NXCD = 8, WGM = 8;

__host__ __device__ __forceinline__ int lds_byte(int r, int c) { const int st = (r >> 4) * 2 + (c >> 5), rr = r & 15, cc = c & 31, ob = rr * 64 + cc * 2; return st * 1024 + (ob ^ (((ob >> 9) & 1) << 5)); }
__host__ __device__ __forceinline__ void stage_rc(int b, int& R, int& C) { const int st = b / 1024, sb = b % 1024, swz = sb ^ (((sb >> 9) & 1) << 5); R = (st >> 1) * 16 + swz / 64; C = (st & 1) * 32 + (swz % 64) / 2; }
__host__ __device__ __forceinline__ int perm32(int rho) { const int n = rho >> 4, i = rho & 15; return 8 * (i >> 2) + 4 * n + (i & 3); }

struct Unit { int pm, pn; };
struct Gemm { const bf16_t* A; const bf16_t* Bt; int M, N, K, lda, ldb; };

struct StaticOrder {
    int nM, nN, nwg, G, c;
    __host__ __device__ void init(int M, int N, int G_, int c_) { nM = M / BM; nN = N / BM; nwg = nM * nN; G = G_; c = c_; }
    __host__ __device__ bool next(int i, Unit& u) const {
        const long L = (long)i * G + c; if (L >= nwg) return false;
        int wgid = (int)L; { const int q = nwg / NXCD, r = nwg % NXCD, xcd = wgid % NXCD, off = wgid / NXCD; wgid = (xcd < r ? xcd * (q + 1) : r * (q + 1) + (xcd - r) * q) + off; }
        const int nig = WGM * nN, gid = wgid / nig, fm = gid * WGM, gsz = (nM - fm) < WGM ? (nM - fm) : WGM;
        u.pm = fm + ((wgid % nig) % gsz); u.pn = (wgid % nig) / gsz; return true;
    }
    __device__ __forceinline__ void a_ready(const Unit&) const {}
    __device__ __forceinline__ void done(const Unit&) const {}
};

__device__ __forceinline__ unsigned cvt_pk_bf16(float lo, float hi) { unsigned r; asm volatile("v_cvt_pk_bf16_f32 %0, %1, %2" : "=v"(r) : "v"(lo), "v"(hi)); return r; }

template <class Epi, class Sched, bool ALIGN_EPI = false, bool SP2 = false>
__device__ __forceinline__ void gemm_phase(PG8_LAS unsigned char* lds, const Gemm g, const Sched& S, const Epi& E) {
    int tid_ = threadIdx.x; asm volatile("" : "+v"(tid_));
    const int tid = tid_, wid = __builtin_amdgcn_readfirstlane(tid >> 6), lane = tid & 63, wr = wid >> 2, wc = wid & 3, fr = lane & 15, fq = lane >> 4;
    const int K = g.K, nt = K / BK;
    unsigned voffA[2], voffB[2];
#pragma unroll
    for (int i = 0; i < 2; ++i) { int R, C; stage_rc(tid * 16 + i * 8192, R, C); const int Rb = Epi::PERM ? ((R & ~31) + perm32(R & 31)) : R;
        voffA[i] = (unsigned)(R * g.lda + C) * 2u; voffB[i] = (unsigned)(Rb * g.ldb + C) * 2u; }
    const size_t kstep = (size_t)(BK * 2);
    const size_t hstepA = (size_t)HALF * g.lda * 2, hstepB = (size_t)HALF * g.ldb * 2;
    const size_t tstepA = 2 * hstepA, tstepB = 2 * hstepB;
    const unsigned ldsw = (unsigned)wid * 1024u;
    const int aoff = lds_byte(wr * 64 + fr, fq * 8), boff = lds_byte(wc * 32 + fr, fq * 8);
#define PG8_SA(b, h) (((b) * 2 + (h)) * HTB)
#define PG8_SB(b, h) ((4 + (b) * 2 + (h)) * HTB)
#define PG8_STAGE(bufoff, gbase, voff) do { _Pragma("unroll") for (int _i = 0; _i < 2; ++_i) \
        __builtin_amdgcn_global_load_lds((const unsigned*)((const char*)(gbase) + (voff)[_i]), (PG8_LAS unsigned*)(lds + (bufoff) + ldsw + _i * 8192), 16, 0, 0); } while (0)
#define PG8_LDA(dst, b, h) do { _Pragma("unroll") for (int m = 0; m < 4; ++m) _Pragma("unroll") for (int k = 0; k < 2; ++k) dst[m][k] = *(const PG8_LAS bf16x8*)(lds + PG8_SA(b, h) + aoff + m * 2048 + k * 1024); } while (0)
#define PG8_LDB(dst, b, h) do { _Pragma("unroll") for (int n = 0; n < 2; ++n) _Pragma("unroll") for (int k = 0; k < 2; ++k) dst[n][k] = *(const PG8_LAS bf16x8*)(lds + PG8_SB(b, h) + boff + n * 2048 + k * 1024); } while (0)
#define PG8_MMA(ai, bj, At, Bt) do { __builtin_amdgcn_s_setprio(1); _Pragma("unroll") for (int m = 0; m < 4; ++m) _Pragma("unroll") for (int n = 0; n < 2; ++n) _Pragma("unroll") for (int k = 0; k < 2; ++k) \
        acc[ai][bj][m][n] = __builtin_amdgcn_mfma_f32_16x16x32_bf16(Bt[n][k], At[m][k], acc[ai][bj][m][n], 0, 0, 0); __builtin_amdgcn_s_setprio(0); } while (0)
#define PG8_WAIT_V(n) asm volatile("s_waitcnt vmcnt(" #n ")" ::: "memory")
#define PG8_WAIT_L(n) asm volatile("s_waitcnt lgkmcnt(" #n ")" ::: "memory")
#define PG8_BAR __builtin_amdgcn_s_barrier()
#define PG8_SCHED __builtin_amdgcn_sched_barrier(0)
    Unit cur, nxt; int ui = 0;
    if (!S.next(0, cur)) return;
    f32x4 acc[2][2][4][2];
#pragma unroll
    for (int a = 0; a < 2; ++a)
#pragma unroll
        for (int b = 0; b < 2; ++b)
#pragma unroll
            for (int m = 0; m < 4; ++m)
#pragma unroll
                for (int n = 0; n < 2; ++n) acc[a][b][m][n] = (f32x4){0.f, 0.f, 0.f, 0.f};
    bf16x8 At[4][2], B0[2][2], B1[2][2];
    const char* cA = (const char*)g.A + (size_t)cur.pm * tstepA; const char* cB = (const char*)g.Bt + (size_t)cur.pn * tstepB;
    S.a_ready(cur);
    if constexpr (SP2) {
        PG8_STAGE(PG8_SB(0, 0), cB, voffB); PG8_STAGE(PG8_SB(0, 1), cB + hstepB, voffB); PG8_STAGE(PG8_SA(0, 0), cA, voffA); PG8_STAGE(PG8_SA(0, 1), cA + hstepA, voffA);
        if (wr == 1) PG8_BAR;
        PG8_WAIT_V(2); PG8_BAR;
        PG8_STAGE(PG8_SB(1, 0), cB + kstep, voffB); PG8_STAGE(PG8_SA(1, 0), cA + kstep, voffA); PG8_STAGE(PG8_SB(1, 1), cB + hstepB + kstep, voffB);
        PG8_WAIT_V(6); PG8_BAR;
    } else {
        PG8_STAGE(PG8_SB(0, 0), cB, voffB); PG8_STAGE(PG8_SA(0, 0), cA, voffA); PG8_STAGE(PG8_SB(0, 1), cB + hstepB, voffB); PG8_STAGE(PG8_SA(0, 1), cA + hstepA, voffA);
        if (wr == 1) PG8_BAR;
        PG8_WAIT_V(4); PG8_BAR;
        PG8_STAGE(PG8_SB(1, 0), cB + kstep, voffB); PG8_STAGE(PG8_SA(1, 0), cA + kstep, voffA); PG8_STAGE(PG8_SB(1, 1), cB + hstepB + kstep, voffB);
        PG8_WAIT_V(6); PG8_BAR;
    }
    for (;;) {
        const bool has_next = S.next(ui + 1, nxt);
        const char* nA = has_next ? (const char*)g.A + (size_t)nxt.pm * tstepA : cA; const char* nB = has_next ? (const char*)g.Bt + (size_t)nxt.pn * tstepB : cB;
        for (int t = 0; t < nt; t += 2) {
            if constexpr (Epi::MIDK) { if (t == (nt >> 1)) E.midk(acc, cur, wr, wc, fr, fq); }
            const bool last = (t == nt - 2);
            const char* a1 = cA + (size_t)(t + 1) * kstep;
            const char* a2 = last ? nA : cA + (size_t)(t + 2) * kstep; const char* b2 = last ? nB : cB + (size_t)(t + 2) * kstep;
            const char* a3 = a2 + kstep; const char* b3 = b2 + kstep;
            if (last && has_next) S.a_ready(nxt);
            if constexpr (SP2) {
            PG8_LDB(B0, 0, 0); PG8_LDB(B1, 0, 1); PG8_SCHED; PG8_LDA(At, 0, 0); PG8_STAGE(PG8_SA(1, 1), a1 + hstepA, voffA);
            PG8_WAIT_V(8); PG8_WAIT_L(0); PG8_BAR; PG8_MMA(0, 0, At, B0); PG8_MMA(0, 1, At, B1); PG8_BAR; PG8_SCHED;
            PG8_LDA(At, 0, 1); PG8_STAGE(PG8_SB(0, 0), b2, voffB); PG8_STAGE(PG8_SB(0, 1), b2 + hstepB, voffB); PG8_STAGE(PG8_SA(0, 0), a2, voffA);
            PG8_WAIT_V(8); PG8_WAIT_L(0); PG8_BAR; PG8_MMA(1, 0, At, B0); PG8_MMA(1, 1, At, B1); PG8_BAR; PG8_SCHED;
            PG8_LDB(B0, 1, 0); PG8_LDB(B1, 1, 1); PG8_SCHED; PG8_LDA(At, 1, 0); PG8_STAGE(PG8_SA(0, 1), a2 + hstepA, voffA);
            PG8_WAIT_V(8); PG8_WAIT_L(0); PG8_BAR; PG8_MMA(0, 0, At, B0); PG8_MMA(0, 1, At, B1); PG8_BAR; PG8_SCHED;
            PG8_LDA(At, 1, 1); PG8_STAGE(PG8_SB(1, 0), b3, voffB); PG8_STAGE(PG8_SB(1, 1), b3 + hstepB, voffB); PG8_STAGE(PG8_SA(1, 0), a3, voffA);
            PG8_WAIT_V(8); PG8_WAIT_L(0); PG8_BAR; PG8_MMA(1, 0, At, B0); PG8_MMA(1, 1, At, B1); PG8_BAR; PG8_SCHED;
            } else {
            PG8_LDB(B0, 0, 0); PG8_SCHED; PG8_LDA(At, 0, 0); PG8_STAGE(PG8_SA(1, 1), a1 + hstepA, voffA);
            PG8_WAIT_L(8); PG8_BAR; PG8_WAIT_L(0); PG8_MMA(0, 0, At, B0); PG8_BAR; PG8_SCHED;
            PG8_LDB(B1, 0, 1); PG8_STAGE(PG8_SB(0, 0), b2, voffB);
            PG8_BAR; PG8_WAIT_L(0); PG8_MMA(0, 1, At, B1); PG8_BAR;
            PG8_LDA(At, 0, 1); PG8_STAGE(PG8_SA(0, 0), a2, voffA);
            PG8_BAR; PG8_WAIT_L(0); PG8_MMA(1, 0, At, B0); PG8_BAR; PG8_SCHED;
            PG8_STAGE(PG8_SB(0, 1), b2 + hstepB, voffB);
            PG8_WAIT_V(6); PG8_BAR; PG8_MMA(1, 1, At, B1); PG8_BAR;
            PG8_LDB(B0, 1, 0); PG8_SCHED; PG8_LDA(At, 1, 0); PG8_STAGE(PG8_SA(0, 1), a2 + hstepA, voffA);
            PG8_WAIT_L(8); PG8_BAR; PG8_WAIT_L(0); PG8_MMA(0, 0, At, B0); PG8_BAR; PG8_SCHED;
            PG8_LDB(B1, 1, 1); PG8_STAGE(PG8_SB(1, 0), b3, voffB);
            PG8_BAR; PG8_WAIT_L(0); PG8_MMA(0, 1, At, B1); PG8_BAR;
            PG8_LDA(At, 1, 1); PG8_STAGE(PG8_SA(1, 0), a3, voffA);
            PG8_BAR; PG8_WAIT_L(0); PG8_MMA(1, 0, At, B0); PG8_BAR; PG8_SCHED;
            PG8_STAGE(PG8_SB(1, 1), b3 + hstepB, voffB);
            PG8_WAIT_V(6); PG8_BAR; PG8_MMA(1, 1, At, B1); PG8_BAR;
            }
        }
        if constexpr (ALIGN_EPI) { if (wr == 0) PG8_BAR; }
        if constexpr (!Epi::AFTER_DRAIN) { E(acc, cur, wr, wc, fr, fq); S.done(cur); }
        if (!has_next) break;
#pragma unroll
        for (int a = 0; a < 2; ++a)
#pragma unroll
            for (int b = 0; b < 2; ++b)
#pragma unroll
                for (int m = 0; m < 4; ++m)
#pragma unroll
                    for (int n = 0; n < 2; ++n) acc[a][b][m][n] = (f32x4){0.f, 0.f, 0.f, 0.f};
        cur = nxt; cA = nA; cB = nB; ++ui;
        if constexpr (ALIGN_EPI) { if (wr == 1) PG8_BAR; }
    }
    PG8_WAIT_V(0);
    if constexpr (!ALIGN_EPI) { if (wr == 0) PG8_BAR; }
    PG8_BAR;
    if constexpr (Epi::AFTER_DRAIN) { E.fused(acc, cur, wr, wc, fr, fq, lds, wid, lane); S.done(cur); }
#undef PG8_SA
#undef PG8_SB
#undef PG8_STAGE
#undef PG8_LDA
#undef PG8_LDB
#undef PG8_MMA
#undef PG8_WAIT_V
#undef PG8_WAIT_L
#undef PG8_BAR
#undef PG8_SCHED
}
}

constexpr int NTOK = 8192, SEQ = 4096, DM = 2048, DC = 1024, DS = 1024, NIN = 3072;
constexpr int NMEMTOK = 512  , HD = 512;
constexpr int PE = 16384;
constexpr float EPS = 1e-6f;
constexpr int NTHREADS = 512, NWAVES = 8;
constexpr int LDS_BYTES = 147456;

#define LAS __attribute__((address_space(3)))
typedef unsigned short bf16;
typedef float f32x4 __attribute__((ext_vector_type(4)));
typedef float f32x2 __attribute__((ext_vector_type(2)));
typedef short bf16x8 __attribute__((ext_vector_type(8)));
typedef unsigned u32x4 __attribute__((ext_vector_type(4)));
typedef unsigned u32x2 __attribute__((ext_vector_type(2)));

constexpr size_t MiB = 1u << 20;
constexpr size_t WS_CTL = 0;
constexpr size_t WS_WIN = 1 * MiB, WS_WKV = 13 * MiB, WS_WGLU = 29 * MiB, WS_WOUT = 31 * MiB, WS_WQ = 39 * MiB, WS_WO = 47 * MiB, WS_WPQ = 55 * MiB;
constexpr size_t WS_KEYS = 59 * MiB;
constexpr size_t WS_PART1 = 60 * MiB, WS_PART2 = 61 * MiB, WS_PARTS = 62 * MiB;
constexpr size_t WS_UB = 64 * MiB, WS_VB = 96 * MiB;
constexpr size_t WS_QSC = 63 * MiB;
constexpr size_t WS_AB = 192 * MiB;
constexpr size_t WS_PROJ = 224 * MiB;
constexpr size_t WS_MEMN = 272 * MiB, WS_KV = 274 * MiB;
constexpr size_t WS_G = 224 * MiB;
constexpr size_t WS_HC = 232 * MiB;
constexpr size_t WS_P = 240 * MiB;
constexpr size_t WS_Z = 278 * MiB;
constexpr size_t WS_YS = 294 * MiB;
constexpr size_t WS_Y = 310 * MiB;
constexpr size_t WS_H = 342 * MiB;
constexpr size_t WS_S5E = 406 * MiB, WS_S5F = 410 * MiB, WS_S5K = 414 * MiB, WS_S5L = 415 * MiB;
constexpr size_t WS_PU = 128 * MiB;
constexpr size_t WS_WP = 416 * MiB;
constexpr size_t WS_WSUM = 420 * MiB;
constexpr size_t WS_PARTF = 421 * MiB;
constexpr size_t WS_END = 422 * MiB;
constexpr int CW_CONVQ = 4096;

struct Args {
    const float* in[31];
    float* out;
    unsigned char* ws;
};

typedef __bf16 bf16x2_t __attribute__((ext_vector_type(2)));
__device__ __forceinline__ unsigned pk2(float lo, float hi) { const f32x2 v = {lo, hi}; return __builtin_bit_cast(unsigned, __builtin_convertvector(v, bf16x2_t)); }
__device__ __forceinline__ unsigned f2bf(float f) { return pk2(f, 0.0f) & 0xffffu; }
__device__ __forceinline__ float bflo(unsigned w) { return __builtin_bit_cast(float, w << 16); }
__device__ __forceinline__ float bfhi(unsigned w) { return __builtin_bit_cast(float, w & 0xffff0000u); }
__device__ __forceinline__ float bf2f(bf16 b) { return __builtin_bit_cast(float, (unsigned)b << 16); }
__device__ __forceinline__ float sigmoidf_(float x) { return __builtin_amdgcn_rcpf(1.0f + __expf(-x)); }
__device__ __forceinline__ float gelu_tanh(float x) { const float u = 1.5957691216057308f * (x + 0.044715f * x * x * x); return x * __builtin_amdgcn_rcpf(1.0f + __expf(-u)); }
__device__ __forceinline__ float wave_sum(float v) {
#pragma unroll
    for (int o = 1; o < 64; o <<= 1) v += __shfl_xor(v, o);
    return v;
}
__device__ __forceinline__ unsigned wave_umax(unsigned v) {
#pragma unroll
    for (int o = 1; o < 64; o <<= 1) { const unsigned t = (unsigned)__shfl_xor((int)v, o); v = t > v ? t : v; }
    return v;
}

template <int MODE, bool MIDK_ = false> struct Epi {
    static constexpr bool PERM = true, AFTER_DRAIN = false, MIDK = MIDK_;
    const float* mpart;
    LAS unsigned char* mlds;
    bf16* ob; int ldo; float cs;
    const float* rpart; int rnp;
    const bf16* zin;
    const float* hin; float* hout;
    float* wpart; int wnp;
    __device__ __forceinline__ void midk(pg8::f32x4 (&acc)[2][2][4][2], const pg8::Unit& u, int wr, int wc, int fr, int fq) const {
        const LAS float* rt = (const LAS float*)mlds;
#pragma unroll
        for (int ai = 0; ai < 2; ++ai)
#pragma unroll
            for (int m = 0; m < 4; ++m) {
                const float r = rt[ai * 128 + wr * 64 + m * 16 + fr];
#pragma unroll
                for (int bj = 0; bj < 2; ++bj) { acc[ai][bj][m][0] = acc[ai][bj][m][0] * r; acc[ai][bj][m][1] = acc[ai][bj][m][1] * r; }
            }
    }
    __device__ __forceinline__ void operator()(const pg8::f32x4 (&acc)[2][2][4][2], const pg8::Unit& u, int wr, int wc, int fr, int fq) const {
#pragma unroll
        for (int ai = 0; ai < 2; ++ai)
#pragma unroll
            for (int m = 0; m < 4; ++m) {
                const int row = u.pm * 256 + ai * 128 + wr * 64 + m * 16 + fr;
                float sc = cs;
                if (MODE == 0 && rpart) {
                    float s = 0.f;
                    for (int i = 0; i < rnp; i += 4) { const f32x4 v = *(const f32x4*)(rpart + (size_t)row * rnp + i); s += (v[0] + v[1]) + (v[2] + v[3]); }
                    sc *= __builtin_amdgcn_rsqf(s * (1.0f / 2048.0f) + EPS);
                }
                float ss = 0.f;
#pragma unroll
                for (int bj = 0; bj < 2; ++bj) {
                    const int col0 = u.pn * 256 + bj * 128 + wc * 32 + 8 * fq;
                    f32x4 v0 = acc[ai][bj][m][0], v1 = acc[ai][bj][m][1];
                    if (MODE == 0) { v0 = v0 * sc; v1 = v1 * sc; }
                    if (MODE == 1) {
                        const u32x4 zw = *(const u32x4*)(zin + (size_t)row * 1024 + col0);
                        v0[0] = bflo(zw[0]) * sigmoidf_(v0[0]); v0[1] = bfhi(zw[0]) * sigmoidf_(v0[1]); v0[2] = bflo(zw[1]) * sigmoidf_(v0[2]); v0[3] = bfhi(zw[1]) * sigmoidf_(v0[3]);
                        v1[0] = bflo(zw[2]) * sigmoidf_(v1[0]); v1[1] = bfhi(zw[2]) * sigmoidf_(v1[1]); v1[2] = bflo(zw[3]) * sigmoidf_(v1[2]); v1[3] = bfhi(zw[3]) * sigmoidf_(v1[3]);
                    }
                    if (MODE == 2) {
                        if (hin) {
                            const f32x4 h0 = *(const f32x4*)(hin + (size_t)row * 2048 + col0), h1 = *(const f32x4*)(hin + (size_t)row * 2048 + col0 + 4);
                            v0 = v0 + h0; v1 = v1 + h1;
                        } else {
                            const u32x4 hw = *(const u32x4*)(zin + (size_t)row * 2048 + col0);
                            v0[0] += bflo(hw[0]); v0[1] += bfhi(hw[0]); v0[2] += bflo(hw[1]); v0[3] += bfhi(hw[1]);
                            v1[0] += bflo(hw[2]); v1[1] += bfhi(hw[2]); v1[2] += bflo(hw[3]); v1[3] += bfhi(hw[3]);
                        }
                    }
                    if (MODE != 0) ss += (v0[0] * v0[0] + v0[1] * v0[1]) + (v0[2] * v0[2] + v0[3] * v0[3]) + (v1[0] * v1[0] + v1[1] * v1[1]) + (v1[2] * v1[2] + v1[3] * v1[3]);
                    u32x4 w; w[0] = pk2(v0[0], v0[1]); w[1] = pk2(v0[2], v0[3]); w[2] = pk2(v1[0], v1[1]); w[3] = pk2(v1[2], v1[3]);
                    *(u32x4*)(ob + (size_t)row * ldo + col0) = w;
                }
                if (MODE != 0) {
                    ss += __shfl_xor(ss, 16); ss += __shfl_xor(ss, 32);
                    if (fq == 0) wpart[(size_t)row * wnp + u.pn * 4 + wc] = ss;
                }
            }
    }
};

struct EpiSoftmax {
    static constexpr bool PERM = true, AFTER_DRAIN = true, MIDK = false;
    bf16* P; int ldp; const float* rpart; float cs;
    __device__ __forceinline__ void fused(pg8::f32x4 (&acc)[2][2][4][2], const pg8::Unit& u, int wr, int wc, int fr, int fq, LAS unsigned char* lds, int wid, int lane) const {
        LAS float* exm = (LAS float*)lds;
        LAS float* exs = exm + 1024;
        float mloc[2][4];
#pragma unroll
        for (int ai = 0; ai < 2; ++ai)
#pragma unroll
            for (int m = 0; m < 4; ++m) {
                const int rl = ai * 128 + wr * 64 + m * 16 + fr, row = u.pm * 256 + rl;
                float s = 0.f;
#pragma unroll
                for (int i = 0; i < 32; i += 4) { const f32x4 v = *(const f32x4*)(rpart + (size_t)row * 32 + i); s += (v[0] + v[1]) + (v[2] + v[3]); }
                const float sc = cs * __builtin_amdgcn_rsqf(s * (1.0f / 2048.0f) + EPS);
                float mx = -3.0e38f;
#pragma unroll
                for (int bj = 0; bj < 2; ++bj)
#pragma unroll
                    for (int n = 0; n < 2; ++n) { acc[ai][bj][m][n] = acc[ai][bj][m][n] * sc; const f32x4 v = acc[ai][bj][m][n]; mx = fmaxf(mx, fmaxf(fmaxf(v[0], v[1]), fmaxf(v[2], v[3]))); }
                mx = fmaxf(mx, __shfl_xor(mx, 16)); mx = fmaxf(mx, __shfl_xor(mx, 32));
                if (fq == 0) exm[rl * 4 + wc] = mx;
            }
        __syncthreads();
#pragma unroll
        for (int ai = 0; ai < 2; ++ai)
#pragma unroll
            for (int m = 0; m < 4; ++m) {
                const int rl = ai * 128 + wr * 64 + m * 16 + fr;
                const f32x4 mv = *(const LAS f32x4*)(exm + rl * 4);
                const float mx = fmaxf(fmaxf(mv[0], mv[1]), fmaxf(mv[2], mv[3]));
                float sm = 0.f;
#pragma unroll
                for (int bj = 0; bj < 2; ++bj)
#pragma unroll
                    for (int n = 0; n < 2; ++n) {
                        f32x4 v = acc[ai][bj][m][n];
                        v[0] = __expf(v[0] - mx); v[1] = __expf(v[1] - mx); v[2] = __expf(v[2] - mx); v[3] = __expf(v[3] - mx);
                        acc[ai][bj][m][n] = v; sm += (v[0] + v[1]) + (v[2] + v[3]);
                    }
                sm += __shfl_xor(sm, 16); sm += __shfl_xor(sm, 32);
                if (fq == 0) exs[rl * 4 + wc] = sm;
                mloc[ai][m] = 0.f;
            }
        __syncthreads();
#pragma unroll
        for (int ai = 0; ai < 2; ++ai)
#pragma unroll
            for (int m = 0; m < 4; ++m) {
                const int rl = ai * 128 + wr * 64 + m * 16 + fr;
                const f32x4 sv = *(const LAS f32x4*)(exs + rl * 4);
                const float inv = __builtin_amdgcn_rcpf((sv[0] + sv[1]) + (sv[2] + sv[3]));
#pragma unroll
                for (int bj = 0; bj < 2; ++bj) {
                    const f32x4 v0 = acc[ai][bj][m][0] * inv, v1 = acc[ai][bj][m][1] * inv;
                    u32x4 w; w[0] = pk2(v0[0], v0[1]); w[1] = pk2(v0[2], v0[3]); w[2] = pk2(v1[0], v1[1]); w[3] = pk2(v1[2], v1[3]);
                    *(u32x4*)(P + (size_t)(u.pm * 256 + rl) * ldp + u.pn * 256 + bj * 128 + wc * 32 + 8 * fq) = w;
                }
            }
        (void)mloc; (void)wid; (void)lane;
        __syncthreads();
    }
};

template <class EPI, bool ALIGN = true> __device__ __forceinline__ void run_gemm(LAS unsigned char* lds, const bf16* A, const bf16* Bt, int M_, int N_, int K_, const EPI& E, int cshift = 0, int lda = 0, int ldb = 0) {
    pg8::Gemm g{A, Bt, M_, N_, K_, lda ? lda : K_, ldb ? ldb : K_}; pg8::StaticOrder S; S.init(M_, N_, (int)gridDim.x, (int)((blockIdx.x + gridDim.x - cshift) % gridDim.x));
    pg8::gemm_phase<EPI, pg8::StaticOrder, ALIGN, true>(lds, g, S, E);
}

__device__ __forceinline__ void quant_rows(const Args& a, int r0, int r1) {
    int tid_ = threadIdx.x; asm volatile("" : "+v"(tid_));
    const int tid = tid_, lane = tid & 63, wave = tid >> 6;
    unsigned char* ws = a.ws;
    const float* gf = a.in[25];
    unsigned char* Uq = ws + WS_UB; unsigned char* Vq = ws + WS_VB;
    float* su = (float*)(ws + WS_QSC); float* sv = su + PE;
#define QR_LOAD(v, r) do { const float* src_ = (((r) < PE) ? a.in[28] + (size_t)(r) * 2048 : a.in[29] + (size_t)((r) - PE) * 2048); \
        _Pragma("unroll") for (int j_ = 0; j_ < 8; ++j_) v[j_] = __builtin_nontemporal_load((const f32x4*)(src_ + 4 * (lane + 64 * j_))); } while (0)
#define QR_PROC(v, r) do { const bool isu_ = (r) < PE; const int e_ = isu_ ? (r) : (r) - PE; float mx_ = 0.f; \
        _Pragma("unroll") for (int j_ = 0; j_ < 8; ++j_) { if (isu_) v[j_] = v[j_] * *(const f32x4*)(gf + 4 * (lane + 64 * j_)); \
            mx_ = fmaxf(mx_, fmaxf(fmaxf(fabsf(v[j_][0]), fabsf(v[j_][1])), fmaxf(fabsf(v[j_][2]), fabsf(v[j_][3])))); } \
        _Pragma("unroll") for (int o_ = 1; o_ < 64; o_ <<= 1) mx_ = fmaxf(mx_, __shfl_xor(mx_, o_)); \
        mx_ = fmaxf(mx_, 1e-30f); const float inv_ = 127.0f * __builtin_amdgcn_rcpf(mx_); unsigned char* tab_ = isu_ ? Uq : Vq; \
        _Pragma("unroll") for (int j_ = 0; j_ < 8; ++j_) { unsigned w_ = 0u; \
            _Pragma("unroll") for (int k_ = 0; k_ < 4; ++k_) { const int q_ = (int)rintf(v[j_][k_] * inv_); w_ |= ((unsigned)q_ & 0xffu) << (8 * k_); } \
            __builtin_nontemporal_store(w_, (unsigned*)(tab_ + ((size_t)(2 * j_ + (lane >> 5)) * PE + e_) * 128 + 4 * (lane & 31))); } \
        if (lane == 0) (isu_ ? su : sv)[e_] = mx_ * (1.0f / 127.0f); } while (0)
    f32x4 va[8], vb[8];
    int r = r0 + wave;
    if (r < r1) QR_LOAD(va, r);
    for (; r < r1; r += 2 * NWAVES) {
        const int rn = r + NWAVES;
        if (rn < r1) QR_LOAD(vb, rn);
        QR_PROC(va, r);
        if (rn < r1) {
            if (rn + NWAVES < r1) QR_LOAD(va, rn + NWAVES);
            QR_PROC(vb, rn);
        }
    }
#undef QR_LOAD
#undef QR_PROC
}

__device__ __forceinline__ void p0_transpose_item(const float* W, int K, int N, bf16* WT, const float* sc0, const float* sc1, int ksplit, LAS float* scr, int item, int lane, int krot = 0) {
    const int nblk = N / 32, kb = item / nblk, nb = item % nblk, k0 = 64 * kb, n0 = 32 * nb;
    f32x4 v[8];
#pragma unroll
    for (int i = 0; i < 8; ++i) {
        const int kk = 8 * i + (lane >> 3), k = (k0 + kk + krot) & (K - 1);
        v[i] = __builtin_nontemporal_load((const f32x4*)(W + (size_t)k * N + n0 + 4 * (lane & 7)));
        if (sc0) v[i] = v[i] * ((k < ksplit) ? sc0[k] : sc1[k - ksplit]);
    }
#pragma unroll
    for (int i = 0; i < 8; ++i) {
        const int kk = 8 * i + (lane >> 3); LAS float* d = scr + kk * 33 + 4 * (lane & 7);
        d[0] = v[i][0]; d[1] = v[i][1]; d[2] = v[i][2]; d[3] = v[i][3];
    }
    asm volatile("s_waitcnt lgkmcnt(0)" ::: "memory");
    const int c = lane & 7;
#pragma unroll
    for (int j = 0; j < 4; ++j) {
        const int n = (lane >> 3) + 8 * j; const LAS float* s = scr + (8 * c) * 33 + n;
        u32x4 o; o[0] = pk2(s[0 * 33], s[1 * 33]); o[1] = pk2(s[2 * 33], s[3 * 33]); o[2] = pk2(s[4 * 33], s[5 * 33]); o[3] = pk2(s[6 * 33], s[7 * 33]);
        *(u32x4*)(WT + (size_t)(n0 + n) * K + k0 + 8 * c) = o;
    }
    asm volatile("s_waitcnt lgkmcnt(0)" ::: "memory");
}
#define RR_LOAD(v, m) do { const float* x_ = ((m) < NTOK) ? a.in[0] + (size_t)(m) * 2048 : a.in[1] + (size_t)((m) - NTOK) * 2048; \
        _Pragma("unroll") for (int j_ = 0; j_ < 8; ++j_) v[j_] = __builtin_nontemporal_load((const f32x4*)(x_ + 4 * (lane + 64 * j_))); } while (0)
#define RR_PROC(v, m) do { const float* gain_ = ((m) < NTOK) ? a.in[2] : a.in[21]; \
        bf16* o_ = ((m) < NTOK) ? (bf16*)(a.ws + WS_AB) + (size_t)(m) * 2048 : (bf16*)(a.ws + WS_MEMN) + (size_t)((m) - NTOK) * 2048; float s_ = 0.f; \
        _Pragma("unroll") for (int j_ = 0; j_ < 8; ++j_) s_ += (v[j_][0] * v[j_][0] + v[j_][1] * v[j_][1]) + (v[j_][2] * v[j_][2] + v[j_][3] * v[j_][3]); \
        const float rinv_ = __builtin_amdgcn_rsqf(wave_sum(s_) * (1.0f / 2048.0f) + EPS); \
        _Pragma("unroll") for (int j_ = 0; j_ < 8; ++j_) { const f32x4 g_ = *(const f32x4*)(gain_ + 4 * (lane + 64 * j_)); \
            u32x2 w_; w_[0] = pk2(v[j_][0] * rinv_ * g_[0], v[j_][1] * rinv_ * g_[1]); w_[1] = pk2(v[j_][2] * rinv_ * g_[2], v[j_][3] * rinv_ * g_[3]); \
            *(u32x2*)(o_ + 4 * (lane + 64 * j_)) = w_; } } while (0)
__device__ __forceinline__ void rms_rows_to_bf16(const Args& a, int m0, int step, int m1, int lane) {
    f32x4 va[8], vb[8];
    int m = m0;
    if (m < m1) RR_LOAD(va, m);
    for (; m < m1; m += 2 * step) {
        const int mn = m + step;
        if (mn < m1) RR_LOAD(vb, mn);
        RR_PROC(va, m);
        if (mn < m1) {
            if (mn + step < m1) RR_LOAD(va, mn + step);
            RR_PROC(vb, mn);
        }
    }
}
__device__ __forceinline__ void s5_tables(const Args& a, LAS unsigned char* lds, int g, int part);
__device__ __forceinline__ void ph_prologue(const Args& a, LAS unsigned char* lds) {
    int tid_ = threadIdx.x; asm volatile("" : "+v"(tid_));
    const int tid = tid_, lane = tid & 63, wave = tid >> 6;
    const int gw = blockIdx.x * NWAVES + wave, NGW = gridDim.x * NWAVES;
    LAS float* scr = (LAS float*)(lds + wave * 16384);
    unsigned char* ws = a.ws;
    for (int j = blockIdx.x; j < 256; j += gridDim.x) s5_tables(a, lds, j >> 2, j & 3);
    constexpr int I_IN = 32 * 96, I_KV = 32 * 128, I_GLU = 16 * 32, I_OUT = 32 * 64, I_O = 32 * 64, I_PQ = 32 * 32;
    constexpr int NIT = I_IN + I_KV + I_GLU + I_OUT + I_O + I_PQ;
    for (int it = gw; it < NIT; it += NGW) {
        int r = it;
        if (r < I_IN) { p0_transpose_item(a.in[3], 2048, 3072, (bf16*)(ws + WS_WIN), nullptr, nullptr, 0, scr, r, lane); continue; } r -= I_IN;
        if (r < I_KV) { p0_transpose_item(a.in[23], 2048, 4096, (bf16*)(ws + WS_WKV), nullptr, nullptr, 0, scr, r, lane); continue; } r -= I_KV;
        if (r < I_GLU) { p0_transpose_item(a.in[16], 1024, 1024, (bf16*)(ws + WS_WGLU), nullptr, nullptr, 0, scr, r, lane); continue; } r -= I_GLU;
        if (r < I_OUT) { p0_transpose_item(a.in[19], 2048, 2048, (bf16*)(ws + WS_WOUT), a.in[17], a.in[18], 1024, scr, r, lane, 1024); continue; } r -= I_OUT;
        if (r < I_O) { p0_transpose_item(a.in[24], 2048, 2048, (bf16*)(ws + WS_WO), nullptr, nullptr, 0, scr, r, lane); continue; } r -= I_O;
        p0_transpose_item(a.in[26], 2048, 1024, (bf16*)(ws + WS_WPQ), a.in[25], a.in[25], 2048, scr, r, lane);
    }
    rms_rows_to_bf16(a, gw, NGW, NTOK + NMEMTOK, lane);
    const size_t gt = (size_t)blockIdx.x * NTHREADS + tid, NGT = (size_t)gridDim.x * NTHREADS;
    for (size_t i = gt; i < (size_t)2048 * 2048 / 8; i += NGT) {
        const float gk = a.in[20][(i * 8) >> 11];
        const f32x4 w0 = __builtin_nontemporal_load((const f32x4*)(a.in[22] + i * 8)), w1 = __builtin_nontemporal_load((const f32x4*)(a.in[22] + i * 8 + 4));
        u32x4 o; o[0] = pk2(w0[0] * gk, w0[1] * gk); o[1] = pk2(w0[2] * gk, w0[3] * gk); o[2] = pk2(w1[0] * gk, w1[1] * gk); o[3] = pk2(w1[2] * gk, w1[3] * gk);
        *(u32x4*)((bf16*)(ws + WS_WQ) + i * 8) = o;
    }
    for (size_t i = gt; i < (size_t)(16 * 128 * 64) / 8; i += NGT) {
        const f32x4 k0 = *(const f32x4*)(a.in[27] + i * 8), k1 = *(const f32x4*)(a.in[27] + i * 8 + 4);
        u32x4 o; o[0] = pk2(k0[0], k0[1]); o[1] = pk2(k0[2], k0[3]); o[2] = pk2(k1[0], k1[1]); o[3] = pk2(k1[2], k1[3]);
        *(u32x4*)((bf16*)(ws + WS_KEYS) + i * 8) = o;
    }
}

__device__ __forceinline__ float wave_sum_dpp(float v) {
    v += __builtin_bit_cast(float, __builtin_amdgcn_update_dpp(0, __builtin_bit_cast(int, v), 0xB1, 0xf, 0xf, false));
    v += __builtin_bit_cast(float, __builtin_amdgcn_update_dpp(0, __builtin_bit_cast(int, v), 0x4E, 0xf, 0xf, false));
    v += __builtin_bit_cast(float, __builtin_amdgcn_update_dpp(0, __builtin_bit_cast(int, v), 0x141, 0xf, 0xf, false));
    v += __builtin_bit_cast(float, __builtin_amdgcn_update_dpp(0, __builtin_bit_cast(int, v), 0x140, 0xf, 0xf, false));
    const int vi = __builtin_bit_cast(int, v);
    return (__builtin_bit_cast(float, __builtin_amdgcn_readlane(vi, 0)) + __builtin_bit_cast(float, __builtin_amdgcn_readlane(vi, 16))) +
           (__builtin_bit_cast(float, __builtin_amdgcn_readlane(vi, 32)) + __builtin_bit_cast(float, __builtin_amdgcn_readlane(vi, 48)));
}
struct ConvState { f32x2 w[31], acc[31]; unsigned pa[16], pg[16]; f32x2 b; f32x4 gg[4], bb[4]; };
__device__ __forceinline__ void conv_norm_row(const LAS float* co, const f32x4 (&gg)[4], const f32x4 (&bb)[4], bf16* yr, int wave, int lane) {
    f32x4 v[4]; float s = 0.f;
#pragma unroll
    for (int i = 0; i < 4; ++i) { v[i] = *(const LAS f32x4*)(co + wave * 1024 + 4 * (lane + 64 * i)); s += (v[i][0] + v[i][1]) + (v[i][2] + v[i][3]); }
    const float mean = wave_sum_dpp(s) * (1.0f / 1024.0f); float q = 0.f;
#pragma unroll
    for (int i = 0; i < 4; ++i) { v[i] = v[i] - mean; q += (v[i][0] * v[i][0] + v[i][1] * v[i][1]) + (v[i][2] * v[i][2] + v[i][3] * v[i][3]); }
    const float rstd = __builtin_amdgcn_rsqf(wave_sum_dpp(q) * (1.0f / 1024.0f) + EPS); float ss = 0.f;
#pragma unroll
    for (int i = 0; i < 4; ++i) {
#pragma unroll
        for (int e = 0; e < 4; ++e) { const float y = v[i][e] * rstd * gg[i][e] + bb[i][e]; const float sw = y * sigmoidf_(y); v[i][e] = sw; ss += sw * sw; }
    }
    const float rinv = __builtin_amdgcn_rsqf(wave_sum_dpp(ss) * (1.0f / 1024.0f) + EPS);
#pragma unroll
    for (int i = 0; i < 4; ++i) { u32x2 o; o[0] = pk2(v[i][0] * rinv, v[i][1] * rinv); o[1] = pk2(v[i][2] * rinv, v[i][3] * rinv); *(u32x2*)(yr + 4 * (lane + 64 * i)) = o; }
}
constexpr int CONV_T = 64, CONV_STEPS = CONV_T + 30, CONV_RING = 16;
template <int TAU> struct ConvStep {
    static __device__ __forceinline__ void run(ConvState& S, const bf16* pbase, int tl0, LAS float* co, bf16* Y, int t0, int tid, int wave, int lane) {
        if constexpr ((TAU & 3) == 0) __builtin_amdgcn_sched_barrier(0);
        const unsigned av = S.pa[TAU % CONV_RING], gv = S.pg[TAU % CONV_RING];
        if constexpr (TAU + CONV_RING < CONV_STEPS) {
            if constexpr (TAU + CONV_RING < 30) {
                const int tl = tl0 - 30 + TAU + CONV_RING, tlc = tl < 0 ? 0 : tl;
                const unsigned va = *(const unsigned*)(pbase + (size_t)tlc * NIN), vg = *(const unsigned*)(pbase + (size_t)tlc * NIN + 1024);
                S.pa[TAU % CONV_RING] = tl < 0 ? 0u : va; S.pg[TAU % CONV_RING] = vg;
            } else {
                const bf16* pp = pbase + (size_t)(tl0 + (TAU + CONV_RING - 30)) * NIN;
                S.pa[TAU % CONV_RING] = *(const unsigned*)pp; S.pg[TAU % CONV_RING] = *(const unsigned*)(pp + 1024);
            }
        }
        const f32x2 x = (f32x2){bflo(av) * sigmoidf_(bflo(gv)), bfhi(av) * sigmoidf_(bfhi(gv))};
#pragma unroll
        for (int j = 0; j < 31; ++j) if (TAU >= 30 || j >= 30 - TAU) S.acc[(TAU + j) % 31] = __builtin_elementwise_fma(S.w[30 - j], x, S.acc[(TAU + j) % 31]);
        constexpr int sl = TAU % 31;
        if constexpr (TAU >= 30) {
            constexpr int row = (TAU - 30) & 7, buf = ((TAU - 30) >> 3) & 1;
            *(LAS f32x2*)(co + buf * 8192 + row * 1024 + 2 * tid) = S.acc[sl];
            if constexpr (row == 7) {
                __syncthreads();
                conv_norm_row(co + buf * 8192, S.gg, S.bb, Y + (size_t)(t0 + (TAU - 37) + wave) * 2048 + 1024, wave, lane);
            }
        }
        S.acc[sl] = S.b;
        ConvStep<TAU + 1>::run(S, pbase, tl0, co, Y, t0, tid, wave, lane);
    }
};
template <> struct ConvStep<CONV_STEPS> {
    static __device__ __forceinline__ void run(ConvState&, const bf16*, int, LAS float*, bf16*, int, int, int, int) {}
};
__device__ __forceinline__ void ph_conv(const Args& a, LAS unsigned char* lds) {
    int tid_ = threadIdx.x; asm volatile("" : "+v"(tid_));
    const int tid = tid_, lane = tid & 63, wave = tid >> 6;
    const bf16* proj = (const bf16*)(a.ws + WS_PROJ);
    bf16* Y = (bf16*)(a.ws + WS_Y);
    LAS float* co = (LAS float*)lds;
    const float* cw = a.in[4]; const float* cb = a.in[5]; const float* lng = a.in[6]; const float* lnb = a.in[7];
    if (blockIdx.x < 128) return;
    ConvState S;
#pragma unroll
    for (int k = 0; k < 31; ++k) S.w[k] = *(const f32x2*)(cw + k * 1024 + 2 * tid);
    S.b = *(const f32x2*)(cb + 2 * tid);
#pragma unroll
    for (int i = 0; i < 4; ++i) { S.gg[i] = *(const f32x4*)(lng + 4 * (lane + 64 * i)); S.bb[i] = *(const f32x4*)(lnb + 4 * (lane + 64 * i)); }
    for (int item = (int)blockIdx.x - 128; item < NTOK / CONV_T; item += 128) {
        const int t0 = item * CONV_T, b = t0 / SEQ, tl0 = t0 % SEQ;
        const bf16* pbase = proj + (size_t)(b * SEQ) * NIN + 2 * tid;
#pragma unroll
        for (int s = 0; s < 31; ++s) S.acc[s] = S.b;
#pragma unroll
        for (int d = 0; d < CONV_RING; ++d) {
            const int tl = tl0 - 30 + d, tlc = tl < 0 ? 0 : tl;
            const unsigned va = *(const unsigned*)(pbase + (size_t)tlc * NIN), vg = *(const unsigned*)(pbase + (size_t)tlc * NIN + 1024);
            S.pa[d] = tl < 0 ? 0u : va; S.pg[d] = vg;
        }
        ConvStep<0>::run(S, pbase, tl0, co, Y, t0, tid, wave, lane);
        __syncthreads();
    }
}

__device__ __forceinline__ void s5_tables(const Args& a, LAS unsigned char* lds, int g, int part) {
    int tid_ = threadIdx.x; asm volatile("" : "+v"(tid_));
    const int tid = tid_;
    LAS float* pwr = (LAS float*)lds;
    LAS float* pwi = pwr + 17 * 64;
    LAS float* bbr = pwi + 17 * 64;
    LAS float* bbi = bbr + 1024;
    LAS float* cr = bbi + 1024;
    LAS float* ci = cr + 1024;
    const float dt = __expf(a.in[10][g]);
    for (int e = tid; e < 17 * 64; e += NTHREADS) {
        const int n = e >> 6, p = e & 63;
        const float lre = a.in[8][g * 64 + p], lim = a.in[9][g * 64 + p];
        const float er = expf((float)n * lre * dt); float sn, cs; sincosf((float)n * lim * dt, &sn, &cs); pwr[e] = er * cs; pwi[e] = er * sn;
    }
    for (int e = tid; e < 1024; e += NTHREADS) {
        const int p = e >> 4, h = e & 15;
        const float lre = a.in[8][g * 64 + p], lim = a.in[9][g * 64 + p];
        const float er = expf(lre * dt); float sn, cs; sincosf(lim * dt, &sn, &cs);
        const float x = er * cs - 1.0f, y = er * sn, den = 1.0f / (lre * lre + lim * lim);
        const float fr = (x * lre + y * lim) * den, fi = (y * lre - x * lim) * den;
        const float br = a.in[11][((size_t)g * 64 + p) * 16 + h], bi = a.in[12][((size_t)g * 64 + p) * 16 + h];
        bbr[e] = fr * br - fi * bi; bbi[e] = fr * bi + fi * br;
        cr[e] = a.in[13][(size_t)g * 1024 + e]; ci[e] = a.in[14][(size_t)g * 1024 + e];
    }
    __syncthreads();
    bf16* E = (bf16*)(a.ws + WS_S5E) + (size_t)g * 32768;
    bf16* F = (bf16*)(a.ws + WS_S5F) + (size_t)g * 32768;
    bf16* K16 = (bf16*)(a.ws + WS_S5K) + (size_t)g * 4096;
    float* L16 = (float*)(a.ws + WS_S5L) + (size_t)g * 128;
    for (int e2 = part * 4096 + tid; e2 < part * 4096 + 4096; e2 += NTHREADS) {
        const int row = e2 >> 7, col = (e2 & 127) * 2, c2 = row >> 6, p = row & 63, j = col >> 4, h0 = col & 15;
        const float pr = pwr[(15 - j) * 64 + p], pi = pwi[(15 - j) * 64 + p];
        float v[2];
#pragma unroll
        for (int t = 0; t < 2; ++t) { const float br = bbr[p * 16 + h0 + t], bi = bbi[p * 16 + h0 + t]; v[t] = c2 ? (pr * bi + pi * br) : (pr * br - pi * bi); }
        *(unsigned*)(E + (size_t)row * 256 + col) = pk2(v[0], v[1]);
    }
    for (int e2 = part * 4096 + tid; e2 < part * 4096 + 4096; e2 += NTHREADS) {
        const int row = e2 >> 6, col = (e2 & 63) * 2, r = row >> 4, h = row & 15, c2 = col >> 6, p0 = col & 63;
        float v[2];
#pragma unroll
        for (int t = 0; t < 2; ++t) {
            const int p = p0 + t; const float pr = pwr[(r + 1) * 64 + p], pi = pwi[(r + 1) * 64 + p], xr = cr[h * 64 + p], xi = ci[h * 64 + p];
            v[t] = c2 ? -(xr * pi + xi * pr) : (xr * pr - xi * pi);
        }
        *(unsigned*)(F + (size_t)row * 128 + col) = pk2(v[0], v[1]);
    }
    {
        const int e2 = part * 512 + tid;
        const int tau = e2 >> 7, h = (e2 >> 3) & 15, hp0 = (e2 & 7) * 2;
        float s0 = 0.f, s1 = 0.f;
        for (int p = 0; p < 64; ++p) {
            const float pr = pwr[tau * 64 + p], pi = pwi[tau * 64 + p], xr = cr[h * 64 + p], xi = ci[h * 64 + p];
            const float wr = xr * pr - xi * pi, wi = xr * pi + xi * pr;
            s0 += wr * bbr[p * 16 + hp0] - wi * bbi[p * 16 + hp0]; s1 += wr * bbr[p * 16 + hp0 + 1] - wi * bbi[p * 16 + hp0 + 1];
        }
        *(unsigned*)(K16 + (size_t)(tau * 16 + h) * 16 + hp0) = pk2(s0, s1);
    }
    if (part == 0 && tid < 64) { L16[tid] = pwr[16 * 64 + tid]; L16[64 + tid] = pwi[16 * 64 + tid]; }
    __syncthreads();
}

__device__ __forceinline__ void ph_s5(const Args& a, LAS unsigned char* lds) {
    int tid_ = threadIdx.x; asm volatile("" : "+v"(tid_));
    const int tid = tid_, lane = tid & 63, wave = __builtin_amdgcn_readfirstlane(tid >> 6), l15 = lane & 15, s4 = lane >> 4;
    const bf16* proj = (const bf16*)(a.ws + WS_PROJ);
    bf16* Z = (bf16*)(a.ws + WS_Z);
    LAS float* lbuf = (LAS float*)(lds + 2 * 33792);
    LAS unsigned char* sb = lds + 2 * 33792 + 33280;
    for (int prob = blockIdx.x; prob < 128; prob += gridDim.x) {
        const int b = prob >> 6, g = prob & 63;
        const bf16* E = (const bf16*)(a.ws + WS_S5E) + (size_t)g * 32768;
        const bf16* F = (const bf16*)(a.ws + WS_S5F) + (size_t)g * 32768;
        const bf16* K16 = (const bf16*)(a.ws + WS_S5K) + (size_t)g * 4096;
        const float* L16 = (const float*)(a.ws + WS_S5L) + (size_t)g * 128;
        const float l16r = L16[lane], l16i = L16[64 + lane];
        float m16r = l16r, m16i = l16i;
#pragma unroll
        for (int q = 0; q < 3; ++q) { const float nr = m16r * m16r - m16i * m16i, ni = 2.0f * m16r * m16i; m16r = nr; m16i = ni; }
        const f32x4 dco = *(const f32x4*)(a.in[15] + g * 16 + 4 * s4);
        bf16x8 ef[8], ff[2][4], kf[2][8];
#pragma unroll
        for (int ks = 0; ks < 8; ++ks) ef[ks] = *(const bf16x8*)(E + (size_t)(16 * wave + l15) * 256 + 8 * s4 + 32 * ks);
#pragma unroll
        for (int rr = 0; rr < 2; ++rr) {
            const int r = wave + 8 * rr;
#pragma unroll
            for (int ks = 0; ks < 4; ++ks) ff[rr][ks] = *(const bf16x8*)(F + (size_t)(16 * r + l15) * 128 + 8 * s4 + 32 * ks);
#pragma unroll
            for (int q = 0; q < 8; ++q) if (rr == 1 || q < 4) {
                const int tau = r - (2 * q + (s4 >> 1)), tc = tau < 0 ? 0 : tau;
                const u32x4 kw = *(const u32x4*)(K16 + (size_t)(tc * 16 + l15) * 16 + 8 * (s4 & 1));
                kf[rr][q] = __builtin_bit_cast(bf16x8, tau < 0 ? (u32x4){0u, 0u, 0u, 0u} : kw);
            }
        }
        float Sr = 0.f, Si = 0.f;
        {
            const size_t segtok0 = (size_t)b * SEQ;
#pragma unroll
            for (int i = 0; i < 2; ++i) {
                const int t2 = tid + i * NTHREADS;
                const bf16* src = proj + (segtok0 + t2) * NIN + 2048 + g * 16;
                const u32x4 v0 = *(const u32x4*)src, v1 = *(const u32x4*)(src + 8);
                LAS unsigned char* dst = lds + (t2 >> 4) * 528 + (t2 & 15) * 32;
                *(LAS u32x4*)dst = v0; *(LAS u32x4*)(dst + 16) = v1;
            }
        }
        __syncthreads();
        for (int seg = 0; seg < 4; ++seg) {
            const size_t segtok0 = (size_t)b * SEQ + seg * 1024;
            LAS unsigned char* useg = lds + (seg & 1) * 33792;
            LAS unsigned char* unext = lds + ((seg + 1) & 1) * 33792;
            u32x4 pf[4];
            if (seg < 3) {
#pragma unroll
                for (int i = 0; i < 2; ++i) {
                    const int t2 = tid + i * NTHREADS;
                    const bf16* src = proj + (segtok0 + 1024 + t2) * NIN + 2048 + g * 16;
                    pf[2 * i] = *(const u32x4*)src; pf[2 * i + 1] = *(const u32x4*)(src + 8);
                }
            }
            {
                f32x4 acc[4];
#pragma unroll
                for (int nb = 0; nb < 4; ++nb) acc[nb] = (f32x4){0.f, 0.f, 0.f, 0.f};
#pragma unroll
                for (int ks = 0; ks < 8; ++ks) {
#pragma unroll
                    for (int nb = 0; nb < 4; ++nb) {
                        const bf16x8 uf = *(const LAS bf16x8*)(useg + (16 * nb + l15) * 528 + (2 * ks + (s4 >> 1)) * 32 + 16 * (s4 & 1));
                        acc[nb] = __builtin_amdgcn_mfma_f32_16x16x32_bf16(ef[ks], uf, acc[nb], 0, 0, 0);
                    }
                    if (ks & 1) __builtin_amdgcn_sched_barrier(0);
                }
#pragma unroll
                for (int nb = 0; nb < 4; ++nb)
#pragma unroll
                    for (int j = 0; j < 4; ++j) lbuf[(16 * wave + 4 * s4 + j) * 65 + 16 * nb + l15] = acc[nb][j];
            }
            __syncthreads();
            LAS float* tend = (LAS float*)(lds + 2 * 33792 + 33280 + 17408);
            {
                float tr = 0.f, ti = 0.f;
#pragma unroll 2
                for (int i = 0; i < 8; ++i) {
                    const int o0 = lane * 65 + 8 * wave + i, o1 = (64 + lane) * 65 + 8 * wave + i;
                    const float lr = lbuf[o0], li = lbuf[o1];
                    lbuf[o0] = tr; lbuf[o1] = ti;
                    const float nr = l16r * tr - l16i * ti + lr, ni = l16r * ti + l16i * tr + li;
                    tr = nr; ti = ni;
                }
                tend[wave * 128 + lane] = tr; tend[wave * 128 + 64 + lane] = ti;
            }
            __syncthreads();
            {
                LAS bf16* sb16 = (LAS bf16*)sb;
                float cr = Sr, ci = Si, myr = 0.f, myi = 0.f;
#pragma unroll
                for (int j = 0; j < 8; ++j) {
                    if (j == wave) { myr = cr; myi = ci; }
                    const float er = tend[j * 128 + lane], ei2 = tend[j * 128 + 64 + lane];
                    const float nr = m16r * cr - m16i * ci + er, ni = m16r * ci + m16i * cr + ei2;
                    cr = nr; ci = ni;
                }
                Sr = cr; Si = ci;
                float pr = 1.f, pi = 0.f;
#pragma unroll 2
                for (int i = 0; i < 8; ++i) {
                    const float t_r = lbuf[lane * 65 + 8 * wave + i], t_i = lbuf[(64 + lane) * 65 + 8 * wave + i];
                    const float sr = t_r + pr * myr - pi * myi, si = t_i + pr * myi + pi * myr;
                    sb16[(8 * wave + i) * 136 + lane] = (bf16)f2bf(sr); sb16[(8 * wave + i) * 136 + 64 + lane] = (bf16)f2bf(si);
                    const float qr = pr * l16r - pi * l16i, qi = pr * l16i + pi * l16r; pr = qr; pi = qi;
                }
            }
            __syncthreads();
#pragma unroll
            for (int rr = 0; rr < 2; ++rr) {
                const int r = wave + 8 * rr;
                f32x4 acc[4];
#pragma unroll
                for (int nb = 0; nb < 4; ++nb) acc[nb] = (f32x4){0.f, 0.f, 0.f, 0.f};
#pragma unroll
                for (int ks = 0; ks < 4; ++ks) {
#pragma unroll
                    for (int nb = 0; nb < 4; ++nb) {
                        const bf16x8 sf = *(const LAS bf16x8*)(sb + (16 * nb + l15) * 272 + (32 * ks + 8 * s4) * 2);
                        acc[nb] = __builtin_amdgcn_mfma_f32_16x16x32_bf16(ff[rr][ks], sf, acc[nb], 0, 0, 0);
                    }
                    if (ks & 1) __builtin_amdgcn_sched_barrier(0);
                }
#pragma unroll
                for (int q = 0; q < 8; ++q) {
                    if ((rr == 1 || q < 4) && 2 * q <= r) {
#pragma unroll
                        for (int nb = 0; nb < 4; ++nb) {
                            const bf16x8 uf = *(const LAS bf16x8*)(useg + (16 * nb + l15) * 528 + (2 * q + (s4 >> 1)) * 32 + 16 * (s4 & 1));
                            acc[nb] = __builtin_amdgcn_mfma_f32_16x16x32_bf16(kf[rr][q], uf, acc[nb], 0, 0, 0);
                        }
                    }
                    if (q & 1) __builtin_amdgcn_sched_barrier(0);
                }
#pragma unroll
                for (int nb = 0; nb < 4; ++nb) {
                    const int sc = 16 * nb + l15;
                    const u32x2 uw = *(const LAS u32x2*)(useg + sc * 528 + r * 32 + 8 * s4);
                    const float y0 = acc[nb][0] + dco[0] * bflo(uw[0]), y1 = acc[nb][1] + dco[1] * bfhi(uw[0]), y2 = acc[nb][2] + dco[2] * bflo(uw[1]), y3 = acc[nb][3] + dco[3] * bfhi(uw[1]);
                    u32x2 o; o[0] = pk2(gelu_tanh(y0), gelu_tanh(y1)); o[1] = pk2(gelu_tanh(y2), gelu_tanh(y3));
                    *(u32x2*)(Z + (segtok0 + 16 * sc + r) * 1024 + g * 16 + 4 * s4) = o;
                }
            }
            if (seg < 3) {
#pragma unroll
                for (int i = 0; i < 2; ++i) {
                    const int t2 = tid + i * NTHREADS;
                    LAS unsigned char* dst = unext + (t2 >> 4) * 528 + (t2 & 15) * 32;
                    *(LAS u32x4*)dst = pf[2 * i]; *(LAS u32x4*)(dst + 16) = pf[2 * i + 1];
                }
            }
            __syncthreads();
        }
    }
}

__device__ __forceinline__ void ph_ysnorm(const Args& a) {
    int tid_ = threadIdx.x; asm volatile("" : "+v"(tid_));
    const int tid = tid_, lane = tid & 63, wave = tid >> 6;
    const int gw = blockIdx.x * NWAVES + wave, NGW = gridDim.x * NWAVES;
    const bf16* ys = (const bf16*)(a.ws + WS_YS); bf16* Y = (bf16*)(a.ws + WS_Y); const float* part = (const float*)(a.ws + WS_PARTS);
    for (int m = gw; m < NTOK; m += NGW) {
        float s = (lane < 16) ? part[(size_t)m * 16 + lane] : 0.f;
        const float rinv = __builtin_amdgcn_rsqf(wave_sum(s) * (1.0f / 1024.0f) + EPS);
#pragma unroll
        for (int j = 0; j < 2; ++j) {
            const u32x4 w = *(const u32x4*)(ys + (size_t)m * 1024 + 8 * (lane + 64 * j));
            u32x4 o;
#pragma unroll
            for (int e = 0; e < 4; ++e) o[e] = pk2(bflo(w[e]) * rinv, bfhi(w[e]) * rinv);
            *(u32x4*)(Y + (size_t)m * 2048 + 1024 + 8 * (lane + 64 * j)) = o;
        }
    }
}

__device__ __forceinline__ unsigned enc_key(float v) { const unsigned b = __builtin_bit_cast(unsigned, v); return b ^ ((b >> 31) ? 0xffffffffu : 0x80000000u); }
__device__ __forceinline__ float dec_key(unsigned o) { const unsigned b = (o & 0x80000000u) ? (o ^ 0x80000000u) : ~o; return __builtin_bit_cast(float, b); }
template <int CTRL> __device__ __forceinline__ unsigned dpp_u(unsigned v) { return (unsigned)__builtin_amdgcn_update_dpp(0, (int)v, CTRL, 0xf, 0xf, false); }
__device__ __forceinline__ unsigned row_umax(unsigned v) {
    unsigned t;
    t = dpp_u<0x128>(v); v = t > v ? t : v;
    t = dpp_u<0x124>(v); v = t > v ? t : v;
    t = dpp_u<0x122>(v); v = t > v ? t : v;
    t = dpp_u<0x121>(v); v = t > v ? t : v;
    return v;
}
#define CSWAP(x, y) do { const unsigned hi_ = (x) > (y) ? (x) : (y), lo_ = (x) > (y) ? (y) : (x); (x) = hi_; (y) = lo_; } while (0)
__device__ __forceinline__ void ph_topk(const Args& a, LAS unsigned char* lds) {
    int tid_ = threadIdx.x; asm volatile("" : "+v"(tid_));
    const int tid = tid_, lane = tid & 63, wave = __builtin_amdgcn_readfirstlane(tid >> 6), l15 = lane & 15, s4 = lane >> 4;
    const bf16* qp = (const bf16*)(a.ws + WS_Z);
    const bf16* keysb = (const bf16*)(a.ws + WS_KEYS);
    int* idxo = (int*)(a.ws + WS_YS); float* gateo = (float*)(a.ws + WS_YS + 4 * MiB);
    LAS float* sc = (LAS float*)(lds + wave * 16448);
    LAS unsigned* lst = (LAS unsigned*)(lds + 8 * 16448) + wave * 128 + s4 * 32;
    const int h = wave;
    bf16x8 kf[2][8][2];
#pragma unroll
    for (int side = 0; side < 2; ++side)
#pragma unroll
        for (int nbl = 0; nbl < 8; ++nbl)
#pragma unroll
            for (int ks = 0; ks < 2; ++ks) kf[side][nbl][ks] = *(const bf16x8*)(keysb + ((size_t)((h * 2 + side) * 128 + 16 * nbl + l15)) * 64 + 32 * ks + 8 * s4);
    for (int item = blockIdx.x; item < NTOK / 32; item += gridDim.x) {
#pragma unroll 1
        for (int sub = 0; sub < 2; ++sub) {
            const int t0 = item * 32 + sub * 16;
            bf16x8 qf[2][2];
#pragma unroll
            for (int side = 0; side < 2; ++side)
#pragma unroll
                for (int ks = 0; ks < 2; ++ks) qf[side][ks] = *(const bf16x8*)(qp + (size_t)(t0 + l15) * 1024 + h * 128 + side * 64 + 32 * ks + 8 * s4);
#pragma unroll
            for (int side = 0; side < 2; ++side)
#pragma unroll
                for (int nbl = 0; nbl < 8; ++nbl) {
                    f32x4 c = {0.f, 0.f, 0.f, 0.f};
#pragma unroll
                    for (int ks = 0; ks < 2; ++ks) c = __builtin_amdgcn_mfma_f32_16x16x32_bf16(qf[side][ks], kf[side][nbl][ks], c, 0, 0, 0);
#pragma unroll
                    for (int j = 0; j < 4; ++j) sc[(4 * s4 + j) * 257 + side * 128 + 16 * nbl + l15] = c[j];
                }
            asm volatile("s_waitcnt lgkmcnt(0)" ::: "memory");
#pragma unroll 1
            for (int tt = 0; tt < 4; ++tt) {
                const int tl = tt * 4 + s4; const LAS float* sr = sc + tl * 257;
                unsigned top[2];
#pragma unroll
                for (int side = 0; side < 2; ++side) {
                    unsigned v[8];
#pragma unroll
                    for (int k = 0; k < 8; ++k) v[k] = (enc_key(sr[side * 128 + l15 + 16 * k]) & ~127u) | (unsigned)(127 - (l15 + 16 * k));
                    CSWAP(v[0], v[1]); CSWAP(v[2], v[3]); CSWAP(v[4], v[5]); CSWAP(v[6], v[7]);
                    CSWAP(v[0], v[2]); CSWAP(v[1], v[3]); CSWAP(v[4], v[6]); CSWAP(v[5], v[7]);
                    CSWAP(v[1], v[2]); CSWAP(v[5], v[6]); CSWAP(v[0], v[4]); CSWAP(v[3], v[7]);
                    CSWAP(v[1], v[5]); CSWAP(v[2], v[6]);
                    CSWAP(v[1], v[4]); CSWAP(v[3], v[6]);
                    CSWAP(v[2], v[4]); CSWAP(v[3], v[5]);
                    CSWAP(v[3], v[4]);
                    unsigned mine = 0u;
#pragma unroll
                    for (int it = 0; it < 16; ++it) {
                        const unsigned m = row_umax(v[0]);
                        const bool win = v[0] == m;
#pragma unroll
                        for (int k = 0; k < 7; ++k) v[k] = win ? v[k + 1] : v[k];
                        v[7] = win ? 0u : v[7];
                        mine = (l15 == it) ? m : mine;
                    }
                    top[side] = mine;
                }
                lst[l15] = top[0]; lst[16 + l15] = top[1];
                asm volatile("s_waitcnt lgkmcnt(0)" ::: "memory");
                const float s1 = dec_key(top[0] & ~127u);
                unsigned c[16];
#pragma unroll
                for (int q = 0; q < 4; ++q) {
                    const u32x4 w = *(const LAS u32x4*)(lst + 16 + 4 * q);
#pragma unroll
                    for (int k = 0; k < 4; ++k) c[4 * q + k] = (enc_key(s1 + dec_key(w[k] & ~127u)) & ~255u) | (unsigned)(255 - (l15 * 16 + 4 * q + k));
                }
                unsigned mine = 0u;
#pragma unroll
                for (int it = 0; it < 16; ++it) {
                    const unsigned m = row_umax(c[0]);
                    const bool win = c[0] == m;
#pragma unroll
                    for (int k = 0; k < 15; ++k) c[k] = win ? c[k + 1] : c[k];
                    c[15] = win ? 0u : c[15];
                    mine = (l15 == it) ? m : mine;
                }
                const float val = dec_key(mine & ~255u);
                float vm = val;
                { float t;
                  t = __builtin_bit_cast(float, dpp_u<0x128>(__builtin_bit_cast(unsigned, vm))); vm = fmaxf(vm, t);
                  t = __builtin_bit_cast(float, dpp_u<0x124>(__builtin_bit_cast(unsigned, vm))); vm = fmaxf(vm, t);
                  t = __builtin_bit_cast(float, dpp_u<0x122>(__builtin_bit_cast(unsigned, vm))); vm = fmaxf(vm, t);
                  t = __builtin_bit_cast(float, dpp_u<0x121>(__builtin_bit_cast(unsigned, vm))); vm = fmaxf(vm, t); }
                const float ex = __expf(val - vm);
                float sm = ex;
                { float t;
                  t = __builtin_bit_cast(float, dpp_u<0x128>(__builtin_bit_cast(unsigned, sm))); sm += t;
                  t = __builtin_bit_cast(float, dpp_u<0x124>(__builtin_bit_cast(unsigned, sm))); sm += t;
                  t = __builtin_bit_cast(float, dpp_u<0x122>(__builtin_bit_cast(unsigned, sm))); sm += t;
                  t = __builtin_bit_cast(float, dpp_u<0x121>(__builtin_bit_cast(unsigned, sm))); sm += t; }
                {
                    const int cand = 255 - (int)(mine & 255u), ia = cand >> 4, ib = cand & 15;
                    const int i1 = 127 - (int)(lst[ia] & 127u), i2 = 127 - (int)(lst[16 + ib] & 127u);
                    const int jp = h * 16 + l15;
                    const size_t o = (size_t)(t0 + tl) * 128 + (jp & 7) * 16 + (jp >> 3);
                    idxo[o] = i1 * 128 + i2; gateo[o] = ex * __builtin_amdgcn_rcpf(sm);
                }
                asm volatile("s_waitcnt lgkmcnt(0)" ::: "memory");
            }
        }
    }
}

__device__ __forceinline__ float cvt_ub(unsigned w, int k) { return (float)((w >> (8 * k)) & 0xffu); }
template <int CTRL> __device__ __forceinline__ float dpp_f(float v) { return __builtin_bit_cast(float, __builtin_amdgcn_update_dpp(0, __builtin_bit_cast(int, v), CTRL, 0xf, 0xf, false)); }
#define PP_LOAD_IDX(ei, tok) do { _Pragma("unroll") for (int q_ = 0; q_ < 4; ++q_) { const u32x4 t_ = *(const u32x4*)(idx + (size_t)(tok) * 128 + pr * 16 + 4 * q_); \
        ei[4 * q_] = (int)t_[0]; ei[4 * q_ + 1] = (int)t_[1]; ei[4 * q_ + 2] = (int)t_[2]; ei[4 * q_ + 3] = (int)t_[3]; } } while (0)
#define PP_G8(ub, ei, o8) do { _Pragma("unroll") for (int i_ = 0; i_ < 8; ++i_) ub[i_] = *(const u32x4*)(slab + ((unsigned)ei[(o8) + i_] * 128u + coff)); } while (0)
#define PU_LOAD_H(hx, tok) do { hx[0] = *(const u32x4*)(h2b + (size_t)(tok) * 2048 + 128 * s + 16 * c); hx[1] = *(const u32x4*)(h2b + (size_t)(tok) * 2048 + 128 * s + 16 * c + 8); } while (0)
template <int CTRL> __device__ __forceinline__ int dpp_i(int v) { return __builtin_amdgcn_update_dpp(0, v, CTRL, 0xf, 0xf, false); }
#define PU_QUANT(hx, hq, hs) do { \
        float f_[16]; _Pragma("unroll") for (int q_ = 0; q_ < 2; ++q_) _Pragma("unroll") for (int e_ = 0; e_ < 4; ++e_) { f_[8 * q_ + 2 * e_] = bflo(hx[q_][e_]); f_[8 * q_ + 2 * e_ + 1] = bfhi(hx[q_][e_]); } \
        float m_ = 0.f; _Pragma("unroll") for (int k_ = 0; k_ < 16; ++k_) m_ = fmaxf(m_, fabsf(f_[k_])); \
        m_ = fmaxf(m_, dpp_f<0xB1>(m_)); m_ = fmaxf(m_, dpp_f<0x4E>(m_)); m_ = fmaxf(m_, dpp_f<0x141>(m_)); m_ = fmaxf(m_, 1e-30f); \
        const float iv_ = 127.0f * __builtin_amdgcn_rcpf(m_); hs = m_ * (1.0f / 127.0f); \
        _Pragma("unroll") for (int q_ = 0; q_ < 4; ++q_) { \
            const int a0_ = (int)rintf(f_[4 * q_] * iv_), a1_ = (int)rintf(f_[4 * q_ + 1] * iv_), a2_ = (int)rintf(f_[4 * q_ + 2] * iv_), a3_ = (int)rintf(f_[4 * q_ + 3] * iv_); \
            hq[q_] = (int)(((unsigned)a0_ & 0xffu) | (((unsigned)a1_ & 0xffu) << 8) | (((unsigned)a2_ & 0xffu) << 16) | ((unsigned)a3_ << 24)); } } while (0)
#define PU_C8(ub, hq, hs, res) do { \
        _Pragma("unroll") for (int i_ = 0; i_ < 8; ++i_) { \
            int d_ = 0; \
            _Pragma("unroll") for (int q_ = 0; q_ < 4; ++q_) d_ = __builtin_amdgcn_sdot4((int)ub[i_][q_], hq[q_], d_, false); \
            d_ += dpp_i<0xB1>(d_); d_ += dpp_i<0x4E>(d_); d_ += dpp_i<0x141>(d_); \
            res = (c == i_) ? (float)d_ * hs : res; } } while (0)
#define PU_STORE(tok, k_, r0, r1) do { LAS float* lp_ = keep + (k_) * 128 + lane; \
        if (pass == 0) { lp_[0] = r0; lp_[64] = r1; } \
        else { float* po_ = pu + ((size_t)x * NTOK + (tok)) * 128 + pr * 16 + c; po_[0] = r0 + lp_[0]; po_[8] = r1 + lp_[64]; } } while (0)
__device__ __forceinline__ void ph_peer_u(const Args& a, LAS unsigned char* lds) {
    int tid_ = threadIdx.x; asm volatile("" : "+v"(tid_));
    const int tid = tid_, lane = tid & 63, wave = tid >> 6, pr = lane >> 3, c = lane & 7;
    const bf16* h2b = (const bf16*)(a.ws + WS_AB);
    const unsigned char* Uq = a.ws + WS_UB;
    const int* idx = (const int*)(a.ws + WS_YS);
    float* pu = (float*)(a.ws + WS_PU);
    const int x = blockIdx.x & 7, nbx = gridDim.x >> 3, bi = blockIdx.x >> 3;
    const int tstride = nbx * NWAVES, tfirst = bi * NWAVES + wave, ntok = NTOK / tstride;
    LAS float* keep = (LAS float*)(lds + wave * 16384);
    const unsigned coff = 16u * (unsigned)c;
    for (int pass = 0; pass < 2; ++pass) {
        const int s = x + 8 * pass;
        const unsigned char* slab = Uq + (size_t)s * PE * 128;
        int eA[16], eB[16]; u32x4 ub0[8], ub1[8]; u32x4 hA[2], hB[2];
        PP_LOAD_IDX(eA, tfirst);
        PP_G8(ub0, eA, 0); PU_LOAD_H(hA, tfirst);
        PP_LOAD_IDX(eB, tfirst + tstride);
        for (int k = 0; k < ntok; k += 2) {
            const int tokA = tfirst + k * tstride, tokB = tokA + tstride;
            const bool more = k + 2 < ntok;
            float r0 = 0.f, r1 = 0.f; int hq[4]; float hs;
            PP_G8(ub1, eA, 8);
            if (more) PP_LOAD_IDX(eA, tokA + 2 * tstride);
            PU_QUANT(hA, hq, hs);
            PU_C8(ub0, hq, hs, r0);
            PP_G8(ub0, eB, 0); PU_LOAD_H(hB, tokB);
            PU_C8(ub1, hq, hs, r1);
            PU_STORE(tokA, k, r0, r1);
            r0 = 0.f; r1 = 0.f;
            PP_G8(ub1, eB, 8);
            if (more) PP_LOAD_IDX(eB, tokB + 2 * tstride);
            PU_QUANT(hB, hq, hs);
            PU_C8(ub0, hq, hs, r0);
            if (more) { PP_G8(ub0, eA, 0); PU_LOAD_H(hA, tokA + 2 * tstride); }
            PU_C8(ub1, hq, hs, r1);
            PU_STORE(tokB, k + 1, r0, r1);
        }
    }
}
__device__ __forceinline__ void ph_peer_w(const Args& a) {
    int tid_ = threadIdx.x; asm volatile("" : "+v"(tid_));
    const int tid = tid_, lane = tid & 63, wave = tid >> 6;
    const float* part = (const float*)(a.ws + WS_PART2);
    const float* su = (const float*)(a.ws + WS_QSC); const float* sv = su + PE;
    const int* idx = (const int*)(a.ws + WS_YS); const float* gate = (const float*)(a.ws + WS_YS + 4 * MiB);
    const float* pu = (const float*)(a.ws + WS_PU);
    unsigned char* wq = (unsigned char*)(a.ws + WS_WP); float* wsc = (float*)(a.ws + WS_WSUM);
    for (int tok = blockIdx.x * NWAVES + wave; tok < NTOK; tok += gridDim.x * NWAVES) {
        const float ps = (lane < 32) ? part[(size_t)tok * 32 + lane] : 0.f;
        const float rinv = __builtin_amdgcn_rsqf(wave_sum(ps) * (1.0f / 2048.0f) + EPS);
        float w[2]; float mx = 0.f;
#pragma unroll
        for (int hh = 0; hh < 2; ++hh) {
            const int pos = lane + 64 * hh;
            float d = 0.f;
#pragma unroll
            for (int s = 0; s < 8; ++s) d += pu[((size_t)s * NTOK + tok) * 128 + pos];
            const int e = idx[(size_t)tok * 128 + pos];
            w[hh] = gate[(size_t)tok * 128 + pos] * gelu_tanh(d * rinv * su[e]) * sv[e];
            mx = fmaxf(mx, fabsf(w[hh]));
        }
#pragma unroll
        for (int o = 1; o < 64; o <<= 1) mx = fmaxf(mx, __shfl_xor(mx, o));
        mx = fmaxf(mx, 1e-30f);
        const float iv = 127.0f * __builtin_amdgcn_rcpf(mx);
#pragma unroll
        for (int hh = 0; hh < 2; ++hh) wq[(size_t)tok * 128 + lane + 64 * hh] = (unsigned char)((int)rintf(w[hh] * iv) & 0xff);
        if (lane == 0) wsc[tok] = mx * (1.0f / 127.0f);
    }
}
#define PV_LOAD_W(wv, tok) do { wv = *(const u32x4*)(wq + (size_t)(tok) * 128 + pr * 16); } while (0)
#define PV_G4(r0, r1, r2, r3, wd, acc) do { _Pragma("unroll") for (int q_ = 0; q_ < 4; ++q_) { \
        const unsigned l01_ = __builtin_amdgcn_perm(r1[q_], r0[q_], 0x05010400u), l23_ = __builtin_amdgcn_perm(r3[q_], r2[q_], 0x05010400u); \
        const unsigned h01_ = __builtin_amdgcn_perm(r1[q_], r0[q_], 0x07030602u), h23_ = __builtin_amdgcn_perm(r3[q_], r2[q_], 0x07030602u); \
        acc[4 * q_ + 0] = __builtin_amdgcn_sdot4((int)__builtin_amdgcn_perm(l23_, l01_, 0x05040100u), (int)(wd), acc[4 * q_ + 0], false); \
        acc[4 * q_ + 1] = __builtin_amdgcn_sdot4((int)__builtin_amdgcn_perm(l23_, l01_, 0x07060302u), (int)(wd), acc[4 * q_ + 1], false); \
        acc[4 * q_ + 2] = __builtin_amdgcn_sdot4((int)__builtin_amdgcn_perm(h23_, h01_, 0x05040100u), (int)(wd), acc[4 * q_ + 2], false); \
        acc[4 * q_ + 3] = __builtin_amdgcn_sdot4((int)__builtin_amdgcn_perm(h23_, h01_, 0x07060302u), (int)(wd), acc[4 * q_ + 3], false); } } while (0)
#define PV_C8(vb, wv, o8, acc) do { PV_G4(vb[0], vb[1], vb[2], vb[3], wv[(o8) / 4], acc); PV_G4(vb[4], vb[5], vb[6], vb[7], wv[(o8) / 4 + 1], acc); } while (0)
#define PV_FINISH(acc, tok) do { \
        int r8_[8]; _Pragma("unroll") for (int k_ = 0; k_ < 8; ++k_) { const int m_ = b2 ? acc[k_ + 8] : acc[k_], o_ = b2 ? acc[k_] : acc[k_ + 8]; r8_[k_] = m_ + __shfl_xor(o_, 32); } \
        int r4_[4]; _Pragma("unroll") for (int k_ = 0; k_ < 4; ++k_) { const int m_ = b1 ? r8_[k_ + 4] : r8_[k_], o_ = b1 ? r8_[k_] : r8_[k_ + 4]; r4_[k_] = m_ + __shfl_xor(o_, 16); } \
        int r2_[2]; _Pragma("unroll") for (int k_ = 0; k_ < 2; ++k_) { const int m_ = b0 ? r4_[k_ + 2] : r4_[k_], o_ = b0 ? r4_[k_] : r4_[k_ + 2]; r2_[k_] = m_ + __shfl_xor(o_, 8); } \
        const float ws_ = wsc[(tok)]; \
        const size_t ho_ = (size_t)(tok) * 2048 + 128 * s + 16 * c + 2 * pr; \
        const unsigned hx_ = *(const unsigned*)(h2b + ho_); \
        const float o0_ = bflo(hx_) + (float)r2_[0] * ws_, o1_ = bfhi(hx_) + (float)r2_[1] * ws_; \
        *(f32x2*)(h3 + ho_) = (f32x2){o0_, o1_}; \
        const float ss_ = wave_sum(o0_ * o0_ + o1_ * o1_); \
        if (lane == 0) partf[(size_t)(tok) * 16 + s] = ss_; \
        _Pragma("unroll") for (int k_ = 0; k_ < 16; ++k_) acc[k_] = 0; } while (0)
__device__ __forceinline__ void ph_peer_v(const Args& a) {
    int tid_ = threadIdx.x; asm volatile("" : "+v"(tid_));
    const int tid = tid_, lane = tid & 63, wave = tid >> 6, pr = lane >> 3, c = lane & 7;
    const bf16* h2b = (const bf16*)(a.ws + WS_AB); float* h3 = (float*)(a.ws + WS_H);
    const unsigned char* Vq = a.ws + WS_VB;
    const int* idx = (const int*)(a.ws + WS_YS);
    const unsigned char* wq = (const unsigned char*)(a.ws + WS_WP); const float* wsc = (const float*)(a.ws + WS_WSUM);
    float* partf = (float*)(a.ws + WS_PARTF);
    const int x = blockIdx.x & 7, nbx = gridDim.x >> 3, bi = blockIdx.x >> 3;
    const bool b2 = (pr & 4) != 0, b1 = (pr & 2) != 0, b0 = (pr & 1) != 0;
    const int tstride = nbx * NWAVES, tfirst = bi * NWAVES + wave, ntok = NTOK / tstride;
    const unsigned coff = 16u * (unsigned)c;
    for (int pass = 0; pass < 2; ++pass) {
        const int s = x + 8 * pass;
        const unsigned char* slab = Vq + (size_t)s * PE * 128;
        int eA[16], eB[16]; u32x4 ub0[8], ub1[8]; u32x4 wA, wB; int acc[16];
#pragma unroll
        for (int k = 0; k < 16; ++k) acc[k] = 0;
        PP_LOAD_IDX(eA, tfirst);
        PP_G8(ub0, eA, 0); PV_LOAD_W(wA, tfirst);
        PP_LOAD_IDX(eB, tfirst + tstride);
        for (int k = 0; k < ntok; k += 2) {
            const int tokA = tfirst + k * tstride, tokB = tokA + tstride;
            const bool more = k + 2 < ntok;
            PP_G8(ub1, eA, 8);
            if (more) PP_LOAD_IDX(eA, tokA + 2 * tstride);
            PV_C8(ub0, wA, 0, acc);
            PP_G8(ub0, eB, 0); PV_LOAD_W(wB, tokB);
            PV_C8(ub1, wA, 8, acc);
            PV_FINISH(acc, tokA);
            PP_G8(ub1, eB, 8);
            if (more) PP_LOAD_IDX(eB, tokB + 2 * tstride);
            PV_C8(ub0, wB, 0, acc);
            if (more) { PP_G8(ub0, eA, 0); PV_LOAD_W(wA, tokA + 2 * tstride); }
            PV_C8(ub1, wB, 8, acc);
            PV_FINISH(acc, tokB);
        }
    }
}
__device__ __forceinline__ void ph_final(const Args& a) {
    int tid_ = threadIdx.x; asm volatile("" : "+v"(tid_));
    const int tid = tid_, lane = tid & 63, wave = tid >> 6;
    const float* h3 = (const float*)(a.ws + WS_H); const float* partf = (const float*)(a.ws + WS_PARTF); const float* gfin = a.in[30];
    const int step = gridDim.x * NWAVES;
#define FN_LOAD(v, ps, tok) do { ps = (lane < 16) ? partf[(size_t)(tok) * 16 + lane] : 0.f; \
        _Pragma("unroll") for (int j_ = 0; j_ < 8; ++j_) v[j_] = __builtin_nontemporal_load((const f32x4*)(h3 + (size_t)(tok) * 2048 + 4 * (lane + 64 * j_))); } while (0)
#define FN_PROC(v, ps, tok) do { const float rf_ = __builtin_amdgcn_rsqf(wave_sum(ps) * (1.0f / 2048.0f) + EPS); \
        _Pragma("unroll") for (int j_ = 0; j_ < 8; ++j_) { const f32x4 g_ = *(const f32x4*)(gfin + 4 * (lane + 64 * j_)); \
            __builtin_nontemporal_store(v[j_] * g_ * rf_, (f32x4*)(a.out + (size_t)(tok) * 2048 + 4 * (lane + 64 * j_))); } } while (0)
    f32x4 va[8], vb[8]; float pa = 0.f, pb = 0.f;
    int tok = blockIdx.x * NWAVES + wave;
    if (tok < NTOK) FN_LOAD(va, pa, tok);
    for (; tok < NTOK; tok += 2 * step) {
        const int tn = tok + step;
        if (tn < NTOK) FN_LOAD(vb, pb, tn);
        FN_PROC(va, pa, tok);
        if (tn < NTOK) {
            if (tn + step < NTOK) FN_LOAD(va, pa, tn + step);
            FN_PROC(vb, pb, tn);
        }
    }
#undef FN_LOAD
#undef FN_PROC
}

#define XB_TMO      128
#define XB_XCNT(j)  (256  + 64 * (j))
#define XB_XSUB(j)  (1280 + 64 * (j))
#define XB_XGEN(j)  (2304 + 64 * (j))
#define XB_TOP      3328
#define XB_TOPGEN   3392
#define XCD_BAR_WORDS 3456
#define XB_SPIN_CAP (1u << 18)
__device__ __forceinline__ unsigned xb_ld(unsigned* p)              { return __hip_atomic_load(p, __ATOMIC_RELAXED, __HIP_MEMORY_SCOPE_AGENT); }
__device__ __forceinline__ unsigned xb_add(unsigned* p, unsigned v) { return __hip_atomic_fetch_add(p, v, __ATOMIC_RELAXED, __HIP_MEMORY_SCOPE_AGENT); }
__device__ __forceinline__ unsigned xb_xcc_id() { return (unsigned)__builtin_amdgcn_s_getreg((3 << 11) | 20) & 0xFu; }
#define XB_SPIN(cond, bar) do { unsigned _sp = 0; while (cond) { __builtin_amdgcn_s_sleep(1); \
    if ((++_sp & 255u) == 0u) { if (xb_ld(&(bar)[XB_TMO])) break; if (_sp > XB_SPIN_CAP) { atomicAdd(&(bar)[XB_TMO], 1u); break; } } } } while (0)
struct XcdBarrier { unsigned* bar; unsigned x; volatile LAS unsigned* st; };
__device__ __forceinline__ XcdBarrier xcd_barrier_post(unsigned* bar, volatile LAS unsigned* st) {
    XcdBarrier b; b.bar = bar; b.x = xb_xcc_id(); b.st = st;
    if (threadIdx.x == 0) (void)xb_add(&bar[XB_XCNT(b.x)], 1u);
    return b;
}
__device__ __forceinline__ void xcd_barrier_complete(unsigned* bar, unsigned x, unsigned& nloc, unsigned& nx) {
    const unsigned G = gridDim.x * gridDim.y * gridDim.z;
    unsigned sum, cnt, mine, sp = 0u;
    for (;;) {
        sum = 0u; cnt = 0u; mine = 0u;
#pragma unroll
        for (unsigned j = 0; j < 16; ++j) { const unsigned c = xb_ld(&bar[XB_XCNT(j)]); sum += c; cnt += (c > 0u) ? 1u : 0u; mine = (j == x) ? c : mine; }
        if (sum == G) break;
        __builtin_amdgcn_s_sleep(1);
        if ((++sp & 255u) == 0u) { if (xb_ld(&bar[XB_TMO])) break; if (sp > XB_SPIN_CAP) { atomicAdd(&bar[XB_TMO], 1u); break; } }
    }
    nloc = mine > 0u ? mine : 1u; nx = cnt > 0u ? cnt : 1u;
}
__device__ __forceinline__ void xcd_barrier(const XcdBarrier& b) {
    asm volatile("s_waitcnt vmcnt(0)" ::: "memory");
    __syncthreads();
    if (threadIdx.x == 0) {
        unsigned* bar = b.bar;
        __builtin_amdgcn_s_waitcnt(0);
        unsigned nloc = b.st[0], nx = b.st[1];
        if (nloc == 0u) { xcd_barrier_complete(bar, b.x, nloc, nx); b.st[0] = nloc; b.st[1] = nx; }
        const unsigned old = xb_add(&bar[XB_XSUB(b.x)], 1u);
        const unsigned gen = old / nloc;
        if (old + 1u == (gen + 1u) * nloc) {
            __builtin_amdgcn_fence(__ATOMIC_RELEASE, "agent");
            asm volatile("s_waitcnt vmcnt(0)" ::: "memory");
            const unsigned og = xb_add(&bar[XB_TOP], 1u);
            const unsigned tg = og / nx;
            if (og + 1u == (tg + 1u) * nx) xb_add(&bar[XB_TOPGEN], 1u);
            else XB_SPIN(xb_ld(&bar[XB_TOPGEN]) == tg, bar);
            __builtin_amdgcn_fence(__ATOMIC_ACQUIRE, "agent");
            xb_add(&bar[XB_XGEN(b.x)], 1u);
            asm volatile("s_waitcnt vmcnt(0)" ::: "memory");
        } else {
            XB_SPIN(xb_ld(&bar[XB_XGEN(b.x)]) == gen, bar);
            __builtin_amdgcn_fence(__ATOMIC_ACQUIRE, "agent");
            asm volatile("s_waitcnt vmcnt(0)" ::: "memory");
        }
    }
    __syncthreads();
}

constexpr int MISC_OFF = LDS_BYTES - 128;
constexpr size_t CTL_ZERO_BYTES = 65536;
__global__ void __launch_bounds__(NTHREADS, 2) __attribute__((target("no-packed-fp32-ops"))) mk_fwd(Args a) {
    extern __shared__ __attribute__((aligned(16))) unsigned char lds_raw[];
    LAS unsigned char* lds = (LAS unsigned char*)lds_raw;
    unsigned char* ws = a.ws;
    for (int u = threadIdx.x; u < 32; u += NTHREADS) ((LAS unsigned*)(lds + MISC_OFF))[u] = 0u;
    __syncthreads();
    (void)xcd_barrier_post((unsigned*)(ws + WS_CTL), (volatile LAS unsigned*)(lds + MISC_OFF) + 8);
#define GRID_BAR() do { XcdBarrier bar_; bar_.bar = (unsigned*)(a.ws + WS_CTL); bar_.x = xb_xcc_id(); bar_.st = (volatile LAS unsigned*)(lds + MISC_OFF) + 8; xcd_barrier(bar_); } while (0)
    ph_prologue(a, lds);
    GRID_BAR();
    {
        { Epi<0> E{nullptr, nullptr, (bf16*)(ws + WS_PROJ), NIN, 1.0f, nullptr, 0, nullptr, nullptr, nullptr, nullptr, 0};
          run_gemm(lds, (const bf16*)(ws + WS_AB), (const bf16*)(ws + WS_WIN), NTOK, NIN, 2048, E); }
        { Epi<0> E{nullptr, nullptr, (bf16*)(ws + WS_KV), 4096, 1.0f, nullptr, 0, nullptr, nullptr, nullptr, nullptr, 0};
          run_gemm(lds, (const bf16*)(ws + WS_MEMN), (const bf16*)(ws + WS_WKV), NMEMTOK, 4096, 2048, E, 128); }
        if (blockIdx.x >= 160) quant_rows(a, ((int)blockIdx.x - 160) * 64, ((int)blockIdx.x - 160) * 64 + 64);
    }
    GRID_BAR();
    ph_conv(a, lds);
    ph_s5(a, lds);
    GRID_BAR();
    {
        { Epi<1> E{nullptr, nullptr, (bf16*)(ws + WS_Y), 2048, 1.0f, nullptr, 0, (const bf16*)(ws + WS_Z), nullptr, nullptr, (float*)(ws + WS_PARTS), 16};
          run_gemm(lds, (const bf16*)(ws + WS_Z), (const bf16*)(ws + WS_WGLU), NTOK, 1024, 1024, E); }
        const bf16* kv = (const bf16*)(ws + WS_KV);
        for (int bh = 0; bh < 8; ++bh) {
            const int b = bh >> 2, h = bh & 3;
            Epi<0> E{nullptr, nullptr, (bf16*)(ws + WS_G) + ((size_t)b * 1024 + h * 256) * 2048, 2048, 1.0f, nullptr, 0, nullptr, nullptr, nullptr, nullptr, 0};
            run_gemm(lds, kv + (size_t)b * 256 * 4096 + h * 512, (const bf16*)(ws + WS_WQ) + h * 512, 256, 2048, 512, E, 128 + 8 * bh, 4096, 2048);
        }
        for (int bh = 0; bh < 8; ++bh) {
            const int b = bh >> 2, h = bh & 3;
            Epi<0> E{nullptr, nullptr, (bf16*)(ws + WS_HC) + (size_t)b * 2048 * 1024 + h * 256, 1024, 1.0f, nullptr, 0, nullptr, nullptr, nullptr, nullptr, 0};
            run_gemm(lds, (const bf16*)(ws + WS_WO) + h * 512, kv + (size_t)b * 256 * 4096 + 2048 + h * 512, 2048, 256, 512, E, 192 + 8 * bh, 2048, 4096);
        }
    }
    GRID_BAR();
    {
        {
            const int c0 = (int)blockIdx.x, wg0 = (c0 & 7) * 32 + (c0 >> 3), pm0 = (wg0 >> 6) * 8 + ((wg0 & 63) & 7);
            const float* mp = (const float*)(ws + WS_PARTS);
            if (threadIdx.x < 256) {
                const int row = pm0 * 256 + (int)threadIdx.x; float s = 0.f;
#pragma unroll
                for (int i = 0; i < 16; i += 4) { const f32x4 v = *(const f32x4*)(mp + (size_t)row * 16 + i); s += (v[0] + v[1]) + (v[2] + v[3]); }
                ((LAS float*)(lds + 131072))[threadIdx.x] = __builtin_amdgcn_rsqf(s * (1.0f / 1024.0f) + EPS);
            }
            __syncthreads();
        }
        Epi<2, true> E{(const float*)(ws + WS_PARTS), lds + 131072, (bf16*)(ws + WS_AB), 2048, 1.0f, nullptr, 0, nullptr, a.in[0], nullptr, (float*)(ws + WS_PART1), 32};
        run_gemm(lds, (const bf16*)(ws + WS_Y), (const bf16*)(ws + WS_WOUT), NTOK, 2048, 2048, E);
    }
    GRID_BAR();
    {
        for (int b = 0; b < 2; ++b) {
            EpiSoftmax E{(bf16*)(ws + WS_P) + (size_t)b * SEQ * 1024, 1024, (const float*)(ws + WS_PART1) + (size_t)b * SEQ * 32, 0.044194173824159216f};
            run_gemm<EpiSoftmax, false>(lds, (const bf16*)(ws + WS_AB) + (size_t)b * SEQ * 2048, (const bf16*)(ws + WS_G) + (size_t)b * 1024 * 2048, SEQ, 1024, 2048, E, 64 * b);
        }
        if (blockIdx.x >= 128) quant_rows(a, 6144 + ((int)blockIdx.x - 128) * 104, 6144 + ((int)blockIdx.x - 128) * 104 + 104);
    }
    GRID_BAR();
    {
        for (int b = 0; b < 2; ++b) {
            Epi<2> E{nullptr, nullptr, (bf16*)(ws + WS_AB) + (size_t)b * SEQ * 2048, 2048, 1.0f, nullptr, 0, (const bf16*)(ws + WS_AB) + (size_t)b * SEQ * 2048, nullptr, nullptr, (float*)(ws + WS_PART2) + (size_t)b * SEQ * 32, 32};
            run_gemm(lds, (const bf16*)(ws + WS_P) + (size_t)b * SEQ * 1024, (const bf16*)(ws + WS_HC) + (size_t)b * 2048 * 1024, SEQ, 2048, 1024, E, 128 * b);
        }
    }
    GRID_BAR();
    {
        Epi<0> E{nullptr, nullptr, (bf16*)(ws + WS_Z), 1024, 1.0f, (const float*)(ws + WS_PART2), 32, nullptr, nullptr, nullptr, nullptr, 0};
        run_gemm(lds, (const bf16*)(ws + WS_AB), (const bf16*)(ws + WS_WPQ), NTOK, 1024, 2048, E);
        if (blockIdx.x >= 128) quant_rows(a, 19456 + ((int)blockIdx.x - 128) * 104, 19456 + ((int)blockIdx.x - 128) * 104 + 104);
    }
    GRID_BAR();
    ph_topk(a, lds);
    GRID_BAR();
    ph_peer_u(a, lds);
    GRID_BAR();
    ph_peer_w(a);
    GRID_BAR();
    ph_peer_v(a);
    GRID_BAR();
    ph_final(a);
}

extern "C" void kernel_launch(void* const* d_in, const int* in_sizes, int n_in, void* d_out, int out_size, void* d_ws, size_t ws_size, hipStream_t stream) {
    if (n_in != 31 || ws_size < WS_END) { fprintf(stderr, "kernel_launch: unexpected inputs (n_in %d, ws %zu)\n", n_in, ws_size); return; }
    static int grid = 0;
    if (grid == 0) {
        int dev = 0, cus = 0, per_cu = 0;
        if (hipGetDevice(&dev) != hipSuccess || hipDeviceGetAttribute(&cus, hipDeviceAttributeMultiprocessorCount, dev) != hipSuccess) { grid = -1; return; }
        if (hipFuncSetAttribute((const void*)mk_fwd, hipFuncAttributeMaxDynamicSharedMemorySize, LDS_BYTES) != hipSuccess) { grid = -1; return; }
        if (hipOccupancyMaxActiveBlocksPerMultiprocessor(&per_cu, (const void*)mk_fwd, NTHREADS, LDS_BYTES) != hipSuccess || per_cu < 1) { fprintf(stderr, "kernel_launch: occupancy query says %d\n", per_cu); }
        (void)hipGetLastError();
        grid = 256;
        if (cus != 256) fprintf(stderr, "kernel_launch: built for 256 CUs, device reports %d\n", cus);
    }
    if (grid < 0) return;
    (void)hipMemsetAsync((char*)d_ws + WS_CTL, 0, CTL_ZERO_BYTES, stream);
    Args a{};
    for (int i = 0; i < 31; ++i) a.in[i] = (const float*)d_in[i];
    a.out = (float*)d_out; a.ws = (unsigned char*)d_ws;
    hipLaunchKernelGGL(mk_fwd, dim3(grid), dim3(NTHREADS), LDS_BYTES, stream, a);
}
```
